# Optimizing an MI355X kernel written in HIP

```python
import jax, jax.numpy as jnp
from jax import lax
import numpy as np

D_MODEL = 1024
BATCH = 8
SEQ = 2048
DEPTH = 2
DEC_BATCH = 128
DEC_SEQ = 8
PAST_LEN = 16384
PAGE_SIZE = 128

H_A = 4
DV_A = D_MODEL // 2 // H_A
DK_A = DV_A // 2
GLA_LOWRANK = 16
GLA_TAU = 16.0
H_B = 4
DV_B = D_MODEL // 2 // H_B
DK_B = 128
H_C = 4
DK_C = D_MODEL // H_C
DV_C = 2 * DK_C
D_FF = ((8 * D_MODEL // 3 + 127) // 128) * 128
CHUNK = 64
ROPE_BASE = 10000.0
EPS = 1e-6
N_EVEN = (DEPTH + 1) // 2
N_ODD = DEPTH // 2
EVEN_SPLITS = (H_A * DK_A, H_A * DK_A, H_A * DV_A, H_A * DV_A, GLA_LOWRANK, H_B * DK_B, H_B * DK_B, H_B * DV_B, H_B * DV_B)
EVEN_IN = sum(EVEN_SPLITS)
ODD_SPLITS = (H_C * DK_C, H_C * DK_C, H_C * DV_C, H_C * DV_C)
ODD_IN = sum(ODD_SPLITS)

kernel_name = 'hybrid_gla_hgrn2_retnet_macaron_decode_step'


def rmsnorm(x, w):
    xf = x.astype(jnp.float32)
    y = xf * lax.rsqrt(jnp.mean(xf * xf, axis=-1, keepdims=True) + EPS)
    return (y * w.astype(jnp.float32)).astype(x.dtype)


def swiglu(x, w_gate, w_up, w_down):
    return (jax.nn.silu(x @ w_gate) * (x @ w_up)) @ w_down


def split_cols(p, sizes):
    return jnp.split(p, np.cumsum(sizes)[:-1].tolist(), axis=-1)


def to_heads(a, n_heads):
    b, t, _ = a.shape
    return a.reshape(b, t, n_heads, -1).transpose(0, 2, 1, 3)


def gated_head_norm(o, gate, w, dtype):
    o = o.astype(jnp.float32)
    y = o * lax.rsqrt(jnp.mean(o * o, axis=-1, keepdims=True) + EPS) * w.astype(jnp.float32) * jax.nn.silu(gate.astype(jnp.float32))
    b, h, t, dv = y.shape
    return y.transpose(0, 2, 1, 3).reshape(b, t, h * dv).astype(dtype)


def rotary(x, pos):
    half = x.shape[-1] // 2
    inv_freq = ROPE_BASE ** (-jnp.arange(half, dtype=jnp.float32) / half)
    ang = pos.astype(jnp.float32)[:, None] * inv_freq[None, :]
    cos, sin = jnp.cos(ang), jnp.sin(ang)
    x1, x2 = x[..., :half], x[..., half:]
    return jnp.concatenate([x1 * cos - x2 * sin, x1 * sin + x2 * cos], axis=-1)


def chunked_decay_attention(q, k, v, log_decay, s0):
    bsz, nh, t, dk = q.shape
    dv = v.shape[-1]
    dg = log_decay.shape[-1]
    c = min(CHUNK, t)
    n = -(-t // c)
    pad = n * c - t
    q, k, v, g = (a.astype(jnp.float32) for a in (q, k, v, log_decay))
    if pad:
        q, k, v, g = (jnp.pad(a, ((0, 0), (0, 0), (0, pad), (0, 0))) for a in (q, k, v, g))

    def to_chunks(a):
        return jnp.moveaxis(a.reshape(bsz, nh, n, c, a.shape[-1]), 2, 0)

    causal = jnp.tril(jnp.ones((c, c), dtype=bool))

    def step(s, blk):
        qc, kc, vc, gc = blk
        b = jnp.cumsum(gc, axis=2)
        diff = b[:, :, :, None, :] - b[:, :, None, :, :]
        dec = jnp.exp(jnp.where(causal[:, :, None], diff, -jnp.inf))
        if dg == 1:
            scores = jnp.einsum('bhtd,bhsd->bhts', qc, kc) * dec[..., 0]
        else:
            scores = jnp.einsum('bhtd,bhsd,bhtsd->bhts', qc, kc, dec)
        o = jnp.einsum('bhts,bhse->bhte', scores, vc) + jnp.einsum('bhtd,bhde->bhte', qc * jnp.exp(b), s)
        b_last = b[:, :, -1:, :]
        s_new = jnp.exp(b_last[:, :, 0, :])[..., None] * s + jnp.einsum('bhsd,bhse->bhde', kc * jnp.exp(b_last - b), vc)
        return s_new, o

    s_fin, o = lax.scan(step, s0.astype(jnp.float32), (to_chunks(q), to_chunks(k), to_chunks(v), to_chunks(g)))
    o = jnp.moveaxis(o, 0, 2).reshape(bsz, nh, n * c, dv)[:, :, :t]
    return o, s_fin.astype(s0.dtype)


def even_mixer(h, s_gla, s_hgrn, w_in, w_gate2, b_gate, gla_norm_w, lb, hgrn_norm_w, w_out):
    q_a, k_a, v_a, r_a, lr_a, q_b, f_b, i_b, g_b = split_cols(h @ w_in, EVEN_SPLITS)
    log_alpha = jax.nn.log_sigmoid((lr_a @ w_gate2 + b_gate).astype(jnp.float32)) / GLA_TAU
    o_a, s_gla_new = chunked_decay_attention(to_heads(q_a, H_A) * (DK_A ** -0.5), to_heads(k_a, H_A), to_heads(v_a, H_A), to_heads(log_alpha, H_A), s_gla)
    y_a = gated_head_norm(o_a, to_heads(r_a, H_A), gla_norm_w, h.dtype)
    lb_h = lb.astype(jnp.float32).reshape(H_B, 1, DK_B)
    f = lb_h + (1.0 - lb_h) * jax.nn.sigmoid(to_heads(f_b, H_B).astype(jnp.float32))
    o_b, s_hgrn_new = chunked_decay_attention(jax.nn.silu(to_heads(q_b, H_B)), 1.0 - f, to_heads(i_b, H_B), jnp.log(f), s_hgrn)
    y_b = gated_head_norm(o_b, to_heads(g_b, H_B), hgrn_norm_w, h.dtype)
    return jnp.concatenate([y_a, y_b], axis=-1) @ w_out, s_gla_new, s_hgrn_new


def odd_mixer(h, pos, s_ret, w_in, ret_norm_w, w_out):
    q, k, v, g = split_cols(h @ w_in, ODD_SPLITS)
    q = rotary(to_heads(q, H_C).astype(jnp.float32), pos)
    k = rotary(to_heads(k, H_C).astype(jnp.float32), pos) * (DK_C ** -0.5)
    b, t, _ = h.shape
    log_gamma = jnp.log(1.0 - 2.0 ** (-5.0 - jnp.arange(H_C, dtype=jnp.float32)))
    ld = jnp.broadcast_to(log_gamma[None, :, None, None], (b, H_C, t, 1))
    o, s_new = chunked_decay_attention(q, k, to_heads(v, H_C), ld, s_ret)
    return gated_head_norm(o, to_heads(g, H_C), ret_norm_w, h.dtype) @ w_out, s_new


def trunk(x, pos, s_gla, s_hgrn, s_ret, norm_w, ffn_w_gate, ffn_w_up, ffn_w_down, even_w_in, gla_w_gate2, gla_b_gate, gla_norm_w, hgrn_lb_table, hgrn_norm_w, even_w_out, odd_w_in, ret_norm_w, odd_w_out):
    lb_all = jnp.cumsum(jax.nn.softmax(hgrn_lb_table.astype(jnp.float32), axis=0), axis=0)
    new_gla, new_hgrn, new_ret = [], [], []
    for l in range(DEPTH):
        nw = norm_w[l]
        x = x + 0.5 * rmsnorm(swiglu(rmsnorm(x, nw[0]), ffn_w_gate[l, 0], ffn_w_up[l, 0], ffn_w_down[l, 0]), nw[1])
        hn = rmsnorm(x, nw[2])
        if l % 2 == 0:
            e = l // 2
            m, sg, sh = even_mixer(hn, s_gla[e], s_hgrn[e], even_w_in[e], gla_w_gate2[e], gla_b_gate[e], gla_norm_w[e], lb_all[l], hgrn_norm_w[e], even_w_out[e])
            new_gla.append(sg)
            new_hgrn.append(sh)
        else:
            o = l // 2
            m, sr = odd_mixer(hn, pos, s_ret[o], odd_w_in[o], ret_norm_w[o], odd_w_out[o])
            new_ret.append(sr)
        x = x + rmsnorm(m, nw[3])
        x = x + 0.5 * rmsnorm(swiglu(rmsnorm(x, nw[4]), ffn_w_gate[l, 1], ffn_w_up[l, 1], ffn_w_down[l, 1]), nw[5])
    return x, jnp.stack(new_gla), jnp.stack(new_hgrn), jnp.stack(new_ret)


def setup_inputs(seed: int = 0) -> dict:
    key = jax.random.key(seed)
    ks = jax.random.split(key, 20)

    def nrm(k, shape, scale):
        return jax.random.normal(k, shape, jnp.float32) * scale

    return {
        'x_prompt': nrm(ks[0], (BATCH, SEQ, D_MODEL), 1.0),
        'x_sample': nrm(ks[1], (DEC_BATCH, DEC_SEQ, D_MODEL), 1.0),
        'state_gla': nrm(ks[2], (N_EVEN, DEC_BATCH, H_A, DK_A, DV_A), 0.5),
        'state_hgrn': nrm(ks[3], (N_EVEN, DEC_BATCH, H_B, DK_B, DV_B), 0.5),
        'state_ret': nrm(ks[4], (N_ODD, DEC_BATCH, H_C, DK_C, DV_C), 0.5),
        'norm_w': 1.0 + nrm(ks[5], (DEPTH, 6, D_MODEL), 0.05),
        'ffn_w_gate': nrm(ks[6], (DEPTH, 2, D_MODEL, D_FF), D_MODEL ** -0.5),
        'ffn_w_up': nrm(ks[7], (DEPTH, 2, D_MODEL, D_FF), D_MODEL ** -0.5),
        'ffn_w_down': nrm(ks[8], (DEPTH, 2, D_FF, D_MODEL), D_FF ** -0.5),
        'even_w_in': nrm(ks[9], (N_EVEN, D_MODEL, EVEN_IN), D_MODEL ** -0.5),
        'gla_w_gate2': nrm(ks[10], (N_EVEN, GLA_LOWRANK, H_A * DK_A), GLA_LOWRANK ** -0.5),
        'gla_b_gate': nrm(ks[11], (N_EVEN, H_A * DK_A), 0.1),
        'gla_norm_w': 1.0 + nrm(ks[12], (N_EVEN, DV_A), 0.05),
        'hgrn_lb_table': nrm(ks[13], (DEPTH + 1, H_B * DK_B), 0.5),
        'hgrn_norm_w': 1.0 + nrm(ks[14], (N_EVEN, DV_B), 0.05),
        'even_w_out': nrm(ks[15], (N_EVEN, H_A * DV_A + H_B * DV_B, D_MODEL), (H_A * DV_A + H_B * DV_B) ** -0.5),
        'odd_w_in': nrm(ks[16], (N_ODD, D_MODEL, ODD_IN), D_MODEL ** -0.5),
        'ret_norm_w': 1.0 + nrm(ks[17], (N_ODD, DV_C), 0.05),
        'odd_w_out': nrm(ks[18], (N_ODD, H_C * DV_C, D_MODEL), (H_C * DV_C) ** -0.5),
    }


def reference(x_prompt, x_sample, state_gla, state_hgrn, state_ret, norm_w, ffn_w_gate, ffn_w_up, ffn_w_down, even_w_in, gla_w_gate2, gla_b_gate, gla_norm_w, hgrn_lb_table, hgrn_norm_w, even_w_out, odd_w_in, ret_norm_w, odd_w_out):
    bp, tp, _ = x_prompt.shape
    ts = x_sample.shape[1]
    pos_p = jnp.arange(tp, dtype=jnp.int32)
    pos_s = PAST_LEN + jnp.arange(ts, dtype=jnp.int32)
    z_gla = jnp.zeros((N_EVEN, bp, H_A, DK_A, DV_A), x_prompt.dtype)
    z_hgrn = jnp.zeros((N_EVEN, bp, H_B, DK_B, DV_B), x_prompt.dtype)
    z_ret = jnp.zeros((N_ODD, bp, H_C, DK_C, DV_C), x_prompt.dtype)
    y_prompt, gla_p, hgrn_p, ret_p = trunk(x_prompt, pos_p, z_gla, z_hgrn, z_ret, norm_w, ffn_w_gate, ffn_w_up, ffn_w_down, even_w_in, gla_w_gate2, gla_b_gate, gla_norm_w, hgrn_lb_table, hgrn_norm_w, even_w_out, odd_w_in, ret_norm_w, odd_w_out)
    y_sample, gla_s, hgrn_s, ret_s = trunk(x_sample, pos_s, state_gla, state_hgrn, state_ret, norm_w, ffn_w_gate, ffn_w_up, ffn_w_down, even_w_in, gla_w_gate2, gla_b_gate, gla_norm_w, hgrn_lb_table, hgrn_norm_w, even_w_out, odd_w_in, ret_norm_w, odd_w_out)
    return (y_prompt, y_sample, gla_p, hgrn_p, ret_p, gla_s, hgrn_s, ret_s)
```

```cpp
#include <hip/hip_runtime.h>
#include <hip/hip_cooperative_groups.h>
#include <cstdio>
#include <cstdint>
namespace cg = cooperative_groups;
__device__ __forceinline__ int otid() { int t = threadIdx.x; asm volatile("" : "+v"(t)); return t; }

namespace pg8 {
#define PG8_LAS __attribute__((address_space(3)))
typedef unsigned short bf16_t;
typedef short bf16x8 __attribute__((ext_vector_type(8)));
typedef float f32x4 __attribute__((ext_vector_type(4)));
typedef unsigned u32x4 __attribute__((ext_vector_type(4)));
constexpr int BM = 256, BK = 64, HALF = 128, HTB = HALF * BK * 2  , STAGE_BYTES = 8 * HTB, NXCD = 8, WGM = 8;

__host__ __device__ __forceinline__ int lds_byte(int r, int c) { const int st = (r >> 4) * 2 + (c >> 5), rr = r & 15, cc = c & 31, ob = rr * 64 + cc * 2; return st * 1024 + (ob ^ (((ob >> 9) & 1) << 5)); }
__host__ __device__ __forceinline__ void stage_rc(int b, int& R, int& C) { const int st = b / 1024, sb = b % 1024, swz = sb ^ (((sb >> 9) & 1) << 5); R = (st >> 1) * 16 + swz / 64; C = (st & 1) * 32 + (swz % 64) / 2; }
__host__ __device__ __forceinline__ int perm32(int rho) { const int n = rho >> 4, i = rho & 15; return 8 * (i >> 2) + 4 * n + (i & 3); }

struct Unit { int pm, pn, ks; };
struct Gemm { const bf16_t* A; const bf16_t* Bt; int M, N, K, ld; };

struct StaticOrder {
    int nM, nN, nwg, G, c;
    int rep;
    __host__ __device__ void init(int M, int N, int G_, int c_, int rep_ = 1) { nM = M / BM; nN = N / BM; nwg = nM * nN; G = G_; c = c_; rep = rep_; }
    __host__ __device__ bool next(int i, Unit& u) const {
        long L = (long)i * G + c; if (L >= (long)nwg * rep) return false; if (L >= nwg) L -= nwg;
        int wgid = (int)L; { const int q = nwg / NXCD, r = nwg % NXCD, xcd = wgid % NXCD, off = wgid / NXCD; wgid = (xcd < r ? xcd * (q + 1) : r * (q + 1) + (xcd - r) * q) + off; }
        const int nig = WGM * nN, gid = wgid / nig, fm = gid * WGM, gsz = (nM - fm) < WGM ? (nM - fm) : WGM;
        u.pm = fm + ((wgid % nig) % gsz); u.pn = (wgid % nig) / gsz; u.ks = 0; return true;
    }
    __device__ __forceinline__ void a_ready(const Unit&) const {}
    __device__ __forceinline__ void done(const Unit&) const {}
};

__device__ __forceinline__ unsigned cvt_pk_bf16(float lo, float hi) { unsigned r; asm volatile("v_cvt_pk_bf16_f32 %0, %1, %2" : "=v"(r) : "v"(lo), "v"(hi)); return r; }
__device__ __forceinline__ float silu_f(float x) { return x * __builtin_amdgcn_rcpf(1.0f + __expf(-x)); }
constexpr int MPROMPT = 16384;

struct EpiSwiGLU { static constexpr bool PERM = true, AFTER_DRAIN = false;
    bf16_t* O; const float* rs;
    __device__ __forceinline__ void operator()(const f32x4 (&acc)[2][2][4][2], const Unit& u, int wr, int wc, int fr, int fq) const {
        const int row0 = u.pm * BM + wr * 64 + fr, col0 = u.pn * HALF + wc * 32 + 8 * fq;
#pragma unroll
        for (int ai = 0; ai < 2; ++ai)
#pragma unroll
            for (int m = 0; m < 4; ++m) { const int row = row0 + ai * HALF + m * 16; const float s = rs[row];
                const f32x4 g0 = acc[ai][0][m][0] * s, g1 = acc[ai][0][m][1] * s, u0 = acc[ai][1][m][0] * s, u1 = acc[ai][1][m][1] * s;
                u32x4 w;
                w.x = cvt_pk_bf16(silu_f(g0[0]) * u0[0], silu_f(g0[1]) * u0[1]); w.y = cvt_pk_bf16(silu_f(g0[2]) * u0[2], silu_f(g0[3]) * u0[3]);
                w.z = cvt_pk_bf16(silu_f(g1[0]) * u1[0], silu_f(g1[1]) * u1[1]); w.w = cvt_pk_bf16(silu_f(g1[2]) * u1[2], silu_f(g1[3]) * u1[3]);
                *(u32x4*)(O + (size_t)row * 2816 + col0) = w; }
    }
};
struct EpiF32SS { static constexpr bool PERM = false, AFTER_DRAIN = false;
    float* O; float* ss;
    __device__ __forceinline__ void operator()(const f32x4 (&acc)[2][2][4][2], const Unit& u, int wr, int wc, int fr, int fq) const {
        const int row0 = u.pm * BM + wr * 64 + fr, col0 = u.pn * BM + wc * 32 + 4 * fq;
#pragma unroll
        for (int ai = 0; ai < 2; ++ai)
#pragma unroll
            for (int m = 0; m < 4; ++m) { const int row = row0 + ai * HALF + m * 16; float q = 0.f;
#pragma unroll
                for (int bj = 0; bj < 2; ++bj)
#pragma unroll
                    for (int n = 0; n < 2; ++n) { const f32x4 v = acc[ai][bj][m][n]; *(f32x4*)(O + (size_t)row * 1024 + col0 + bj * HALF + n * 16) = v;
                        q += (v[0] * v[0] + v[1] * v[1]) + (v[2] * v[2] + v[3] * v[3]); }
                q += __shfl_xor(q, 16); q += __shfl_xor(q, 32);
                if (fq == 0) ss[(size_t)row * 16 + u.pn * 4 + wc] = q; }
    }
};
struct SplitOrder {
    int S, nun, G, c;
    __host__ __device__ void init(int S_, int G_, int c_) { S = S_; nun = 16 * S_; G = G_; c = c_; }
    __host__ __device__ bool next(int i, Unit& u) const { const int L = i * G + c; if (L >= nun) return false; const int tile = L / S; u.ks = L - tile * S; u.pm = 64 + (tile >> 2); u.pn = tile & 3; return true; }
    __device__ __forceinline__ void a_ready(const Unit&) const {}
    __device__ __forceinline__ void done(const Unit&) const {}
};
struct EpiF32 { static constexpr bool PERM = false, AFTER_DRAIN = false;
    float* O;
    __device__ __forceinline__ void operator()(const f32x4 (&acc)[2][2][4][2], const Unit& u, int wr, int wc, int fr, int fq) const {
        const int row0 = u.pm * BM + wr * 64 + fr, col0 = u.pn * BM + wc * 32 + 4 * fq;
#pragma unroll
        for (int ai = 0; ai < 2; ++ai)
#pragma unroll
            for (int m = 0; m < 4; ++m) { const int row = row0 + ai * HALF + m * 16;
#pragma unroll
                for (int bj = 0; bj < 2; ++bj)
#pragma unroll
                    for (int n = 0; n < 2; ++n) *(f32x4*)(O + (size_t)row * 1024 + col0 + bj * HALF + n * 16) = acc[ai][bj][m][n]; }
    }
};
struct EpiB16 { static constexpr bool PERM = true, AFTER_DRAIN = false;
    bf16_t* O;
    __device__ __forceinline__ void operator()(const f32x4 (&acc)[2][2][4][2], const Unit& u, int wr, int wc, int fr, int fq) const {
        const int row0 = u.pm * BM + wr * 64 + fr, col0 = u.pn * BM + wc * 32 + 8 * fq;
#pragma unroll
        for (int ai = 0; ai < 2; ++ai)
#pragma unroll
            for (int m = 0; m < 4; ++m) { const int row = row0 + ai * HALF + m * 16;
#pragma unroll
                for (int bj = 0; bj < 2; ++bj) { const f32x4 v0 = acc[ai][bj][m][0], v1 = acc[ai][bj][m][1]; u32x4 w;
                    w.x = cvt_pk_bf16(v0[0], v0[1]); w.y = cvt_pk_bf16(v0[2], v0[3]); w.z = cvt_pk_bf16(v1[0], v1[1]); w.w = cvt_pk_bf16(v1[2], v1[3]);
                    *(u32x4*)(O + (size_t)row * 1024 + col0 + bj * HALF) = w; } }
    }
};
struct EpiPart { static constexpr bool PERM = false, AFTER_DRAIN = false;
    float* O;
    __device__ __forceinline__ void operator()(const f32x4 (&acc)[2][2][4][2], const Unit& u, int wr, int wc, int fr, int fq) const {
        const int row0 = (u.pm - 64) * BM + wr * 64 + fr, col0 = u.pn * BM + wc * 32 + 4 * fq;
        float* Ob = O + (size_t)u.ks * 1024 * 1024;
#pragma unroll
        for (int ai = 0; ai < 2; ++ai)
#pragma unroll
            for (int m = 0; m < 4; ++m) { const int row = row0 + ai * HALF + m * 16;
#pragma unroll
                for (int bj = 0; bj < 2; ++bj)
#pragma unroll
                    for (int n = 0; n < 2; ++n) *(f32x4*)(Ob + (size_t)row * 1024 + col0 + bj * HALF + n * 16) = acc[ai][bj][m][n]; }
    }
};
struct EpiScale { static constexpr bool PERM = true, AFTER_DRAIN = false;
    bf16_t* O; int ldc; const float* rs;
    __device__ __forceinline__ void operator()(const f32x4 (&acc)[2][2][4][2], const Unit& u, int wr, int wc, int fr, int fq) const {
        const int row0 = u.pm * BM + wr * 64 + fr, col0 = u.pn * BM + wc * 32 + 8 * fq;
#pragma unroll
        for (int ai = 0; ai < 2; ++ai)
#pragma unroll
            for (int m = 0; m < 4; ++m) { const int row = row0 + ai * HALF + m * 16; const float s = rs[row];
#pragma unroll
                for (int bj = 0; bj < 2; ++bj) { const f32x4 v0 = acc[ai][bj][m][0] * s, v1 = acc[ai][bj][m][1] * s; u32x4 w;
                    w.x = cvt_pk_bf16(v0[0], v0[1]); w.y = cvt_pk_bf16(v0[2], v0[3]); w.z = cvt_pk_bf16(v1[0], v1[1]); w.w = cvt_pk_bf16(v1[2], v1[3]);
                    *(u32x4*)(O + (size_t)row * ldc + col0 + bj * HALF) = w; } }
    }
};
struct EpiRet { static constexpr bool PERM = true, AFTER_DRAIN = false;
    bf16_t* O; const float* rs; const float* cosT; const float* sinT;
    __device__ __forceinline__ void operator()(const f32x4 (&acc)[2][2][4][2], const Unit& u, int wr, int wc, int fr, int fq) const {
        const int row0 = u.pm * BM + wr * 64 + fr, col0 = u.pn * BM + wc * 32 + 8 * fq;
        const bool rot = u.pn < 8; const int hh = u.pn & 3; const bool isk = u.pn >= 4;
        const float l2g = __log2f(1.0f - exp2f(-5.0f - (float)hh));
#pragma unroll
        for (int ai = 0; ai < 2; ++ai)
#pragma unroll
            for (int m = 0; m < 4; ++m) { const int row = row0 + ai * HALF + m * 16; float s = rs[row];
                if (!rot) {
#pragma unroll
                    for (int bj = 0; bj < 2; ++bj) { const f32x4 v0 = acc[ai][bj][m][0] * s, v1 = acc[ai][bj][m][1] * s; u32x4 w;
                        w.x = cvt_pk_bf16(v0[0], v0[1]); w.y = cvt_pk_bf16(v0[2], v0[3]); w.z = cvt_pk_bf16(v1[0], v1[1]); w.w = cvt_pk_bf16(v1[2], v1[3]);
                        *(u32x4*)(O + (size_t)row * 6144 + col0 + bj * HALF) = w; }
                } else {
                    int pi; float sc;
                    if (row < MPROMPT) { const int pos = row & 2047, tau = pos & 255; pi = pos;
                        sc = isk ? exp2f((float)(128 - tau) * l2g) * 0.0625f : exp2f((float)(tau - 128) * l2g); }
                    else { pi = 2048 + (row & 7); sc = isk ? 0.0625f : 1.0f; }
                    s *= sc;
                    const int fi = wc * 32 + 8 * fq;
                    const f32x4 c0 = *(const f32x4*)(cosT + pi * 128 + fi), c1 = *(const f32x4*)(cosT + pi * 128 + fi + 4);
                    const f32x4 s0 = *(const f32x4*)(sinT + pi * 128 + fi), s1 = *(const f32x4*)(sinT + pi * 128 + fi + 4);
                    const f32x4 a0 = acc[ai][0][m][0] * s, a1 = acc[ai][0][m][1] * s, b0 = acc[ai][1][m][0] * s, b1 = acc[ai][1][m][1] * s;
                    const f32x4 p0 = a0 * c0 - b0 * s0, p1 = a1 * c1 - b1 * s1, q0 = a0 * s0 + b0 * c0, q1 = a1 * s1 + b1 * c1;
                    u32x4 w;
                    w.x = cvt_pk_bf16(p0[0], p0[1]); w.y = cvt_pk_bf16(p0[2], p0[3]); w.z = cvt_pk_bf16(p1[0], p1[1]); w.w = cvt_pk_bf16(p1[2], p1[3]);
                    *(u32x4*)(O + (size_t)row * 6144 + col0) = w;
                    w.x = cvt_pk_bf16(q0[0], q0[1]); w.y = cvt_pk_bf16(q0[2], q0[3]); w.z = cvt_pk_bf16(q1[0], q1[1]); w.w = cvt_pk_bf16(q1[2], q1[3]);
                    *(u32x4*)(O + (size_t)row * 6144 + col0 + HALF) = w;
                } }
    }
};

template <class Epi, class Sched, bool ALIGN_EPI = false, bool SP2 = false>
__device__ __forceinline__ void gemm_phase(PG8_LAS unsigned char* lds, const Gemm g, const Sched& S, const Epi& E) {
    const int tid = otid(), wid = __builtin_amdgcn_readfirstlane(tid >> 6), lane = tid & 63, wr = wid >> 2, wc = wid & 3, fr = lane & 15, fq = lane >> 4;
    const int K = g.K, nt = K / BK;
    unsigned voffA[2], voffB[2];
#pragma unroll
    for (int i = 0; i < 2; ++i) { int R, C; stage_rc(tid * 16 + i * 8192, R, C); const int Rb = Epi::PERM ? ((R & ~31) + perm32(R & 31)) : R;
        voffA[i] = (unsigned)(R * g.ld + C) * 2u; voffB[i] = (unsigned)(Rb * g.ld + C) * 2u; }
    const size_t kstep = (size_t)(BK * 2);
    const size_t hstep = (size_t)HALF * g.ld * 2;
    const size_t tstep = 2 * hstep;
    const unsigned ldsw = (unsigned)wid * 1024u;
    const int aoff = lds_byte(wr * 64 + fr, fq * 8), boff = lds_byte(wc * 32 + fr, fq * 8);
#define PG8_SA(b, h) (((b) * 2 + (h)) * HTB)
#define PG8_SB(b, h) ((4 + (b) * 2 + (h)) * HTB)
#define PG8_STAGE(bufoff, gbase, voff) do { _Pragma("unroll") for (int _i = 0; _i < 2; ++_i) \
        __builtin_amdgcn_global_load_lds((const unsigned*)((const char*)(gbase) + (voff)[_i]), (PG8_LAS unsigned*)(lds + (bufoff) + ldsw + _i * 8192), 16, 0, 0); } while (0)
#define PG8_LDA(dst, b, h) do { _Pragma("unroll") for (int m = 0; m < 4; ++m) _Pragma("unroll") for (int k = 0; k < 2; ++k) dst[m][k] = *(const PG8_LAS bf16x8*)(lds + PG8_SA(b, h) + aoff + m * 2048 + k * 1024); } while (0)
#define PG8_LDB(dst, b, h) do { _Pragma("unroll") for (int n = 0; n < 2; ++n) _Pragma("unroll") for (int k = 0; k < 2; ++k) dst[n][k] = *(const PG8_LAS bf16x8*)(lds + PG8_SB(b, h) + boff + n * 2048 + k * 1024); } while (0)
#define PG8_MMA(ai, bj, At, Bt) do { __builtin_amdgcn_s_setprio(1); _Pragma("unroll") for (int m = 0; m < 4; ++m) _Pragma("unroll") for (int n = 0; n < 2; ++n) _Pragma("unroll") for (int k = 0; k < 2; ++k) \
        acc[ai][bj][m][n] = __builtin_amdgcn_mfma_f32_16x16x32_bf16(Bt[n][k], At[m][k], acc[ai][bj][m][n], 0, 0, 0); __builtin_amdgcn_s_setprio(0); } while (0)
#define PG8_WAIT_V(n) asm volatile("s_waitcnt vmcnt(" #n ")" ::: "memory")
#define PG8_WAIT_L(n) asm volatile("s_waitcnt lgkmcnt(" #n ")" ::: "memory")
#define PG8_BAR __builtin_amdgcn_s_barrier()
#define PG8_SCHED __builtin_amdgcn_sched_barrier(0)
    Unit cur, nxt; int ui = 0;
    if (!S.next(0, cur)) return;
    f32x4 acc[2][2][4][2];
#pragma unroll
    for (int a = 0; a < 2; ++a)
#pragma unroll
        for (int b = 0; b < 2; ++b)
#pragma unroll
            for (int m = 0; m < 4; ++m)
#pragma unroll
                for (int n = 0; n < 2; ++n) acc[a][b][m][n] = (f32x4){0.f, 0.f, 0.f, 0.f};
    bf16x8 At[4][2], B0[2][2], B1[2][2];
    const char* cA = (const char*)g.A + (size_t)cur.pm * tstep + (size_t)cur.ks * K * 2; const char* cB = (const char*)g.Bt + (size_t)cur.pn * tstep + (size_t)cur.ks * K * 2;
    S.a_ready(cur);
    if constexpr (SP2) {
        PG8_STAGE(PG8_SB(0, 0), cB, voffB); PG8_STAGE(PG8_SB(0, 1), cB + hstep, voffB); PG8_STAGE(PG8_SA(0, 0), cA, voffA); PG8_STAGE(PG8_SA(0, 1), cA + hstep, voffA);
        if (wr == 1) PG8_BAR;
        PG8_WAIT_V(2); PG8_BAR;
        PG8_STAGE(PG8_SB(1, 0), cB + kstep, voffB); PG8_STAGE(PG8_SA(1, 0), cA + kstep, voffA); PG8_STAGE(PG8_SB(1, 1), cB + hstep + kstep, voffB);
        PG8_WAIT_V(6); PG8_BAR;
    } else {
        PG8_STAGE(PG8_SB(0, 0), cB, voffB); PG8_STAGE(PG8_SA(0, 0), cA, voffA); PG8_STAGE(PG8_SB(0, 1), cB + hstep, voffB); PG8_STAGE(PG8_SA(0, 1), cA + hstep, voffA);
        if (wr == 1) PG8_BAR;
        PG8_WAIT_V(4); PG8_BAR;
        PG8_STAGE(PG8_SB(1, 0), cB + kstep, voffB); PG8_STAGE(PG8_SA(1, 0), cA + kstep, voffA); PG8_STAGE(PG8_SB(1, 1), cB + hstep + kstep, voffB);
        PG8_WAIT_V(6); PG8_BAR;
    }
    for (;;) {
        const bool has_next = S.next(ui + 1, nxt);
        const char* nA = has_next ? (const char*)g.A + (size_t)nxt.pm * tstep + (size_t)nxt.ks * K * 2 : cA; const char* nB = has_next ? (const char*)g.Bt + (size_t)nxt.pn * tstep + (size_t)nxt.ks * K * 2 : cB;
        for (int t = 0; t < nt; t += 2) {
            const bool last = (t == nt - 2);
            const char* a1 = cA + (size_t)(t + 1) * kstep;
            const char* a2 = last ? nA : cA + (size_t)(t + 2) * kstep; const char* b2 = last ? nB : cB + (size_t)(t + 2) * kstep;
            const char* a3 = a2 + kstep; const char* b3 = b2 + kstep;
            if (last && has_next) S.a_ready(nxt);
            if constexpr (SP2) {
            PG8_LDB(B0, 0, 0); PG8_LDB(B1, 0, 1); PG8_SCHED; PG8_LDA(At, 0, 0); PG8_STAGE(PG8_SA(1, 1), a1 + hstep, voffA);
            PG8_WAIT_V(8); PG8_WAIT_L(0); PG8_BAR; PG8_MMA(0, 0, At, B0); PG8_MMA(0, 1, At, B1); PG8_BAR; PG8_SCHED;
            PG8_LDA(At, 0, 1); PG8_STAGE(PG8_SB(0, 0), b2, voffB); PG8_STAGE(PG8_SB(0, 1), b2 + hstep, voffB); PG8_STAGE(PG8_SA(0, 0), a2, voffA);
            PG8_WAIT_V(8); PG8_WAIT_L(0); PG8_BAR; PG8_MMA(1, 0, At, B0); PG8_MMA(1, 1, At, B1); PG8_BAR; PG8_SCHED;
            PG8_LDB(B0, 1, 0); PG8_LDB(B1, 1, 1); PG8_SCHED; PG8_LDA(At, 1, 0); PG8_STAGE(PG8_SA(0, 1), a2 + hstep, voffA);
            PG8_WAIT_V(8); PG8_WAIT_L(0); PG8_BAR; PG8_MMA(0, 0, At, B0); PG8_MMA(0, 1, At, B1); PG8_BAR; PG8_SCHED;
            PG8_LDA(At, 1, 1); PG8_STAGE(PG8_SB(1, 0), b3, voffB); PG8_STAGE(PG8_SB(1, 1), b3 + hstep, voffB); PG8_STAGE(PG8_SA(1, 0), a3, voffA);
            PG8_WAIT_V(8); PG8_WAIT_L(0); PG8_BAR; PG8_MMA(1, 0, At, B0); PG8_MMA(1, 1, At, B1); PG8_BAR; PG8_SCHED;
            } else {
            PG8_LDB(B0, 0, 0); PG8_SCHED; PG8_LDA(At, 0, 0); PG8_STAGE(PG8_SA(1, 1), a1 + hstep, voffA);
            PG8_WAIT_L(8); PG8_BAR; PG8_WAIT_L(0); PG8_MMA(0, 0, At, B0); PG8_BAR; PG8_SCHED;
            PG8_LDB(B1, 0, 1); PG8_STAGE(PG8_SB(0, 0), b2, voffB);
            PG8_BAR; PG8_WAIT_L(0); PG8_MMA(0, 1, At, B1); PG8_BAR;
            PG8_LDA(At, 0, 1); PG8_STAGE(PG8_SA(0, 0), a2, voffA);
            PG8_BAR; PG8_WAIT_L(0); PG8_MMA(1, 0, At, B0); PG8_BAR; PG8_SCHED;
            PG8_STAGE(PG8_SB(0, 1), b2 + hstep, voffB);
            PG8_WAIT_V(6); PG8_BAR; PG8_MMA(1, 1, At, B1); PG8_BAR;
            PG8_LDB(B0, 1, 0); PG8_SCHED; PG8_LDA(At, 1, 0); PG8_STAGE(PG8_SA(0, 1), a2 + hstep, voffA);
            PG8_WAIT_L(8); PG8_BAR; PG8_WAIT_L(0); PG8_MMA(0, 0, At, B0); PG8_BAR; PG8_SCHED;
            PG8_LDB(B1, 1, 1); PG8_STAGE(PG8_SB(1, 0), b3, voffB);
            PG8_BAR; PG8_WAIT_L(0); PG8_MMA(0, 1, At, B1); PG8_BAR;
            PG8_LDA(At, 1, 1); PG8_STAGE(PG8_SA(1, 0), a3, voffA);
            PG8_BAR; PG8_WAIT_L(0); PG8_MMA(1, 0, At, B0); PG8_BAR; PG8_SCHED;
            PG8_STAGE(PG8_SB(1, 1), b3 + hstep, voffB);
            PG8_WAIT_V(6); PG8_BAR; PG8_MMA(1, 1, At, B1); PG8_BAR;
            }
        }
        if constexpr (ALIGN_EPI) { if (wr == 0) PG8_BAR; }
        if constexpr (!Epi::AFTER_DRAIN) { E(acc, cur, wr, wc, fr, fq); S.done(cur); }
        if (!has_next) break;
#pragma unroll
        for (int a = 0; a < 2; ++a)
#pragma unroll
            for (int b = 0; b < 2; ++b)
#pragma unroll
                for (int m = 0; m < 4; ++m)
#pragma unroll
                    for (int n = 0; n < 2; ++n) acc[a][b][m][n] = (f32x4){0.f, 0.f, 0.f, 0.f};
        cur = nxt; cA = nA; cB = nB; ++ui;
        if constexpr (ALIGN_EPI) { if (wr == 1) PG8_BAR; }
    }
    PG8_WAIT_V(0);
    if constexpr (!ALIGN_EPI) { if (wr == 0) PG8_BAR; }
    PG8_BAR;
    if constexpr (Epi::AFTER_DRAIN) { E.fused(acc, cur, wr, wc, fr, fq, lds, wid, lane); S.done(cur); }
#undef PG8_SA
#undef PG8_SB
#undef PG8_STAGE
#undef PG8_LDA
#undef PG8_LDB
#undef PG8_MMA
#undef PG8_WAIT_V
#undef PG8_WAIT_L
#undef PG8_BAR
#undef PG8_SCHED
}
}

#define LAS __attribute__((address_space(3)))
typedef unsigned short bf16_t;
typedef short bf16x8 __attribute__((ext_vector_type(8)));
typedef float f32x4 __attribute__((ext_vector_type(4)));
typedef unsigned u32x4 __attribute__((ext_vector_type(4)));
typedef unsigned u32x2 __attribute__((ext_vector_type(2)));
typedef LAS unsigned char* ldsp;

constexpr int D = 1024, FF = 2816, MP = 16384, MS = 1024, M = MP + MS, NUP = 2 * FF, NE = 3840, NO = 6144;
constexpr float EPS = 1e-6f;
constexpr int E_QA = 0, E_KA = 256, E_VA = 512, E_RA = 1024, E_QB = 1536, E_FB = 2048, E_IB = 2560, E_GB = 3072, E_LR = 3584;
constexpr int O_Q = 0, O_K = 1024, O_V = 2048, O_G = 4096;
constexpr int NTHREADS = 512;
constexpr int LDS_BYTES = 155648;
#ifndef TREP_UP
#define TREP_UP 1
#endif
#ifndef TREP_IN
#define TREP_IN 1
#endif
#ifndef TREP_DN
#define TREP_DN 1
#endif
#ifndef REP_P0
#define REP_P0 1
#endif
#ifndef REP_ME
#define REP_ME 1
#endif
#ifndef REP_MO
#define REP_MO 1
#endif
#ifndef REP_OA
#define REP_OA 1
#endif
#ifndef REP_OB
#define REP_OB 1
#endif
#ifndef REP_OS
#define REP_OS 1
#endif
#ifndef REP_OC
#define REP_OC 1
#endif
#ifndef REP_UP
#define REP_UP 1
#endif
#ifndef REP_G
#define REP_G 1
#endif
#ifndef REP_M
#define REP_M 1
#endif
#ifndef EXTRA_SYNCS
#define EXTRA_SYNCS 0
#endif
#ifndef STOPAT
#define STOPAT 1000
#endif
#ifndef PHMASK
#define PHMASK 0xFFFF
#define DBGSKIP 0
#define NANFIX2 1
#endif

constexpr size_t al256(size_t x) { return (x + 255) & ~(size_t)255; }
constexpr size_t SZ_WUP = (size_t)NUP * D * 2, SZ_WDN = (size_t)D * FF * 2;
constexpr size_t WS_WUP = 0;
constexpr size_t WS_WDN = WS_WUP + 4 * SZ_WUP;
constexpr size_t WS_WINE = WS_WDN + 4 * SZ_WDN;
constexpr size_t WS_WOUTE = WS_WINE + (size_t)NE * D * 2;
constexpr size_t WS_WINO = WS_WOUTE + (size_t)D * D * 2;
constexpr size_t WS_WOUTO = WS_WINO + (size_t)NO * D * 2;
constexpr size_t WS_XB = WS_WOUTO + (size_t)D * 2048 * 2;
constexpr size_t WS_RS = WS_XB + (size_t)M * D * 2;
constexpr size_t WS_SS = WS_RS + al256((size_t)M * 4);
constexpr size_t WS_ACT = WS_SS + al256((size_t)M * 16 * 4);
constexpr size_t WS_F = WS_ACT + (size_t)M * FF * 2;
constexpr size_t WS_P = WS_F + (size_t)M * D * 4;
constexpr size_t WS_Y = WS_P + (size_t)M * NO * 2;
constexpr size_t WS_QT = WS_Y + (size_t)M * 2048 * 2;
constexpr size_t WS_QH = WS_QT + (size_t)MP * 768 * 2;
constexpr size_t WS_KT = WS_QH + (size_t)MP * 768 * 2;
constexpr size_t WS_HL = WS_KT + (size_t)MP * 768 * 2;
constexpr size_t HL_HGRN = (size_t)1024 * 128 * 64 * 4;
constexpr size_t WS_DEC = WS_HL + (size_t)134217728;
constexpr size_t DEC_HGRN = (size_t)1024 * 64 * 4;
constexpr size_t WS_ST = WS_DEC + (size_t)1048576;
constexpr size_t ST_HGRN = (size_t)1024 * 128 * 64 * 2;
constexpr size_t WS_COS = WS_ST + (size_t)67108864;
constexpr size_t WS_SIN = WS_COS + al256((size_t)2056 * 128 * 4);
constexpr size_t WS_BAR = WS_SIN + al256((size_t)2056 * 128 * 4);
constexpr size_t WS_PART = WS_BAR + 16384;
constexpr size_t WS_END = WS_PART + (size_t)11 * 1024 * 1024 * 4;

constexpr size_t OUT_GLA_P = 17825792, OUT_HGRN_P = 18087936, OUT_RET_P = 18612224, OUT_GLA_S = 22806528, OUT_HGRN_S = 27000832, OUT_RET_S = 35389440;

struct Params { const float* in[19]; float* out; unsigned char* ws; };

__device__ __forceinline__ unsigned f2bf(float f) { unsigned u = __builtin_bit_cast(unsigned, f); return (u + 0x7fffu + ((u >> 16) & 1u)) >> 16; }
__device__ __forceinline__ float bf2f(unsigned u) { return __builtin_bit_cast(float, u << 16); }
__device__ __forceinline__ unsigned pk2(float lo, float hi) { return pg8::cvt_pk_bf16(lo, hi); }
__device__ __forceinline__ float siluf(float x) { return x * __builtin_amdgcn_rcpf(1.0f + __expf(-x)); }
__device__ __forceinline__ float wave_sum(float v) {
#pragma unroll
    for (int o = 1; o < 64; o <<= 1) v += __shfl_xor(v, o);
    return v;
}
__device__ __forceinline__ f32x4 mma16(bf16x8 a, bf16x8 b, f32x4 c) { return __builtin_amdgcn_mfma_f32_16x16x32_bf16(a, b, c, 0, 0, 0); }
__device__ __forceinline__ bf16x8 ldfrag(ldsp base, int elem) { return *(const LAS bf16x8*)(base + (size_t)elem * 2); }
__device__ __forceinline__ float logsig(float x) { return fminf(x, 0.f) - __logf(1.0f + __expf(-fabsf(x))); }

template <int F> __device__ __forceinline__ void stage_rows(ldsp dst, int dp, const bf16_t* src, size_t sp, int tid) {
    constexpr int G8 = F / 8;
#pragma unroll
    for (int it = 0; it < (64 * G8) / NTHREADS; ++it) { const int idx = tid + it * NTHREADS; const int s = idx / G8, g = idx % G8;
        const u32x4 w = *(const u32x4*)(src + (size_t)s * sp + g * 8);
        *(LAS u32x4*)(dst + (size_t)(s * dp + g * 8) * 2) = w; }
}
template <int F> __device__ __forceinline__ void stage_T(ldsp dst, int dp_unused, const bf16_t* src, size_t sp, int wave, int lane) {
    const bf16_t* gb = src + (size_t)(32 * (wave & 1) + (lane & 31)) * sp + (2 * (wave >> 1) + (lane >> 5)) * 8;
    ldsp base = dst + (size_t)((2 * (wave >> 1) + (lane >> 5)) * 8 * 72 + 32 * (wave & 1) + (lane & 31)) * 2;
    constexpr int UF = (F / 64 > 2) ? 2 : F / 64;
#pragma unroll UF
    for (int it = 0; it < F / 64; ++it) { const u32x4 w = *(const u32x4*)(gb + 64 * it);
#pragma unroll
        for (int i = 0; i < 4; ++i) {
            *(LAS bf16_t*)(base + (64 * it + 2 * i) * 144) = (bf16_t)(w[i] & 0xffffu);
            *(LAS bf16_t*)(base + (64 * it + 2 * i + 1) * 144) = (bf16_t)(w[i] >> 16); } }
}

template <int F> __device__ __forceinline__ void ld_rows(u32x4 (&r)[(64 * (F / 8)) / NTHREADS], const bf16_t* src, size_t sp, int tid) {
    constexpr int G8 = F / 8;
#pragma unroll
    for (int it = 0; it < (64 * G8) / NTHREADS; ++it) { const int idx = tid + it * NTHREADS; const int s = idx / G8, g = idx % G8; r[it] = *(const u32x4*)(src + (size_t)s * sp + g * 8); }
}
template <int F> __device__ __forceinline__ void st_rows(ldsp dst, int dp, const u32x4 (&r)[(64 * (F / 8)) / NTHREADS], int tid) {
    constexpr int G8 = F / 8;
#pragma unroll
    for (int it = 0; it < (64 * G8) / NTHREADS; ++it) { const int idx = tid + it * NTHREADS; const int s = idx / G8, g = idx % G8; *(LAS u32x4*)(dst + (size_t)(s * dp + g * 8) * 2) = r[it]; }
}
template <int F> __device__ __forceinline__ void ld_T(u32x4 (&r)[F / 64], const bf16_t* src, size_t sp, int wave, int lane) {
    const bf16_t* base = src + (size_t)(32 * (wave & 1) + (lane & 31)) * sp + (2 * (wave >> 1) + (lane >> 5)) * 8;
#pragma unroll
    for (int it = 0; it < F / 64; ++it) r[it] = *(const u32x4*)(base + 64 * it);
}
template <int F> __device__ __forceinline__ void st_T(ldsp dst, int dp_unused, const u32x4 (&r)[F / 64], int wave, int lane) {
    ldsp base = dst + (size_t)((2 * (wave >> 1) + (lane >> 5)) * 8 * 72 + 32 * (wave & 1) + (lane & 31)) * 2;
#pragma unroll
    for (int it = 0; it < F / 64; ++it) { const u32x4 w = r[it];
#pragma unroll
        for (int i = 0; i < 4; ++i) {
            *(LAS bf16_t*)(base + (64 * it + 2 * i) * 144) = (bf16_t)(w[i] & 0xffffu);
            *(LAS bf16_t*)(base + (64 * it + 2 * i + 1) * 144) = (bf16_t)(w[i] >> 16); } }
}
__device__ __forceinline__ void row_pass(const Params& p, int mode, float coef, const float* nw, int nsplit) {
    const int tid = otid(), lane = tid & 63, wave = tid >> 6;
    const int gw = blockIdx.x * 8 + wave, NGW = gridDim.x * 8;
    float* RS = (float*)(p.ws + WS_RS); const bf16_t* Fb = (const bf16_t*)(p.ws + WS_F); bf16_t* XB = (bf16_t*)(p.ws + WS_XB);
    const bool xcd_map = gridDim.x == 256; const int wx = (blockIdx.x >> 3) * 8 + wave;
    for (int it = 0; it < (xcd_map ? 9 : (M + NGW - 1) / NGW); ++it) {
        int r;
        if (xcd_map) { if (it < 8) r = 2048 * (blockIdx.x & 7) + wx + 256 * it; else { r = MP + gw; if (gw >= MS) break; } }
        else { r = gw + it * NGW; if (r >= M) break; }
        u32x2* B2 = (u32x2*)(XB + (size_t)r * D);
        f32x4 v[4];
        if (mode == 0) { const f32x4* s4 = (r < MP) ? (const f32x4*)(p.in[0] + (size_t)r * D) : (const f32x4*)(p.in[1] + (size_t)(r - MP) * D);
#pragma unroll
            for (int j = 0; j < 4; ++j) v[j] = __builtin_nontemporal_load(s4 + 64 * j + lane);
        } else { f32x4 fv[4]; u32x2 xw[4];
#pragma unroll
            for (int j = 0; j < 4; ++j) xw[j] = B2[64 * j + lane];
            if (r < MP) { const u32x2* F2 = (const u32x2*)(Fb + (size_t)r * D);
#pragma unroll
                for (int j = 0; j < 4; ++j) { const u32x2 w = __builtin_nontemporal_load(F2 + 64 * j + lane); fv[j] = (f32x4){bf2f(w.x & 0xffffu), bf2f(w.x >> 16), bf2f(w.y & 0xffffu), bf2f(w.y >> 16)}; }
            } else { const f32x4* P4 = (const f32x4*)(p.ws + WS_PART) + (size_t)(r - MP) * 256;
#pragma unroll
                for (int j = 0; j < 4; ++j) fv[j] = (f32x4){0.f, 0.f, 0.f, 0.f};
                for (int ks = 0; ks < nsplit; ++ks) {
#pragma unroll
                    for (int j = 0; j < 4; ++j) fv[j] += __builtin_nontemporal_load(P4 + (size_t)ks * 262144 + 64 * j + lane); } }
            float q = 0.f;
#pragma unroll
            for (int j = 0; j < 4; ++j) q += (fv[j][0] * fv[j][0] + fv[j][1] * fv[j][1]) + (fv[j][2] * fv[j][2] + fv[j][3] * fv[j][3]);
            q = wave_sum(q);
            const float rstd = rsqrtf(q * (1.0f / D) + EPS) * coef; const f32x4* W4 = (const f32x4*)nw;
#pragma unroll
            for (int j = 0; j < 4; ++j) { const f32x4 xv = (f32x4){bf2f(xw[j].x & 0xffffu), bf2f(xw[j].x >> 16), bf2f(xw[j].y & 0xffffu), bf2f(xw[j].y >> 16)};
                v[j] = xv + fv[j] * W4[64 * j + lane] * rstd; }
        }
        if (mode == 2) { f32x4* X4 = (f32x4*)(p.out + (size_t)r * D);
#pragma unroll
            for (int j = 0; j < 4; ++j) X4[64 * j + lane] = v[j];
        } else {
            float s = 0.f;
#pragma unroll
            for (int j = 0; j < 4; ++j) s += (v[j][0] * v[j][0] + v[j][1] * v[j][1]) + (v[j][2] * v[j][2] + v[j][3] * v[j][3]);
            s = wave_sum(s);
#pragma unroll
            for (int j = 0; j < 4; ++j) { u32x2 w; w.x = pk2(v[j][0], v[j][1]); w.y = pk2(v[j][2], v[j][3]); B2[64 * j + lane] = w; }
            if (lane == 0) RS[r] = rsqrtf(s * (1.0f / D) + EPS);
        }
    }
}

__device__ __forceinline__ int dst_row(int n, int mode) {
    if (mode == 1) return ((n >> 7) << 8) + (n & 127);
    if (mode == 2) return ((n >> 7) << 8) + 128 + (n & 127);
    if (mode == 3) return n < 1536 ? n : (n < 1552 ? n + 2048 : n - 16);
    return n;
}
__device__ __forceinline__ void transpose_item(const float* W, int K, int N, bf16_t* WT, int mode, const float* ksc, LAS float* scr, int item, int lane) {
    const int nblk = (N + 31) / 32, kb = item / nblk, nb = item % nblk, k0 = 64 * kb, n0 = 32 * nb;
    const int nn = n0 + (lane & 31);
    float tv[32];
#pragma unroll
    for (int i = 0; i < 32; ++i) { const int kk = 2 * i + (lane >> 5); tv[i] = (nn < N) ? __builtin_nontemporal_load(W + (size_t)(k0 + kk) * N + nn) : 0.f; }
#pragma unroll
    for (int i = 0; i < 32; ++i) { const int kk = 2 * i + (lane >> 5); float v = tv[i]; if (ksc) v *= ksc[k0 + kk]; scr[kk * 33 + (lane & 31)] = v; }
    asm volatile("s_waitcnt lgkmcnt(0)" ::: "memory");
    const int c = lane & 7;
#pragma unroll
    for (int j = 0; j < 4; ++j) { const int nl = (lane >> 3) + 8 * j; const LAS float* s = scr + (8 * c) * 33 + nl;
        u32x4 o; o.x = pk2(s[0 * 33], s[1 * 33]); o.y = pk2(s[2 * 33], s[3 * 33]); o.z = pk2(s[4 * 33], s[5 * 33]); o.w = pk2(s[6 * 33], s[7 * 33]);
        if (n0 + nl < N) *(u32x4*)(WT + (size_t)dst_row(n0 + nl, mode) * K + k0 + 8 * c) = o; }
    asm volatile("s_waitcnt lgkmcnt(0)" ::: "memory");
}
__device__ __forceinline__ void prologue(const Params& p, ldsp lds) {
    const int tid = otid(), lane = tid & 63, wave = tid >> 6;
    LAS float* scr = (LAS float*)(lds + wave * 16384);
    const int gw = blockIdx.x * 8 + wave, NGW = gridDim.x * 8;
    const float* nw = p.in[5];
    constexpr int I_UP = 16 * 88, I_DN = 44 * 32, I_EI = 16 * 113, I_EO = 16 * 32, I_OI = 16 * 192, I_OO = 32 * 32;
    constexpr int NITEMS = 8 * I_UP + 4 * I_DN + I_EI + I_EO + I_OI + I_OO;
    for (int it = gw; it < NITEMS; it += NGW) {
        int r = it;
        if (r < 8 * I_UP) { const int f = r / (2 * I_UP), rr = r % (2 * I_UP), isup = rr >= I_UP, ii = rr % I_UP; const int l = f >> 1, j = f & 1;
            transpose_item((isup ? p.in[7] : p.in[6]) + (size_t)f * D * FF, D, FF, (bf16_t*)(p.ws + WS_WUP + f * SZ_WUP), isup ? 2 : 1, nw + (l * 6 + (j ? 4 : 0)) * D, scr, ii, lane); continue; }
        r -= 8 * I_UP;
        if (r < 4 * I_DN) { const int f = r / I_DN, ii = r % I_DN;
            transpose_item(p.in[8] + (size_t)f * FF * D, FF, D, (bf16_t*)(p.ws + WS_WDN + f * SZ_WDN), 0, nullptr, scr, ii, lane); continue; }
        r -= 4 * I_DN;
        if (r < I_EI) { transpose_item(p.in[9], D, 3600, (bf16_t*)(p.ws + WS_WINE), 3, nw + 2 * D, scr, r, lane); continue; }
        r -= I_EI;
        if (r < I_EO) { transpose_item(p.in[15], D, D, (bf16_t*)(p.ws + WS_WOUTE), 0, nullptr, scr, r, lane); continue; }
        r -= I_EO;
        if (r < I_OI) { transpose_item(p.in[16], D, NO, (bf16_t*)(p.ws + WS_WINO), 0, nw + 8 * D, scr, r, lane); continue; }
        r -= I_OI;
        transpose_item(p.in[18], 2048, D, (bf16_t*)(p.ws + WS_WOUTO), 0, nullptr, scr, r, lane);
    }
    const int gtid = blockIdx.x * NTHREADS + tid, GT = gridDim.x * NTHREADS;
    { u32x4* z = (u32x4*)(p.ws + WS_WINE + (size_t)3600 * D * 2); for (int i = gtid; i < 240 * D / 8; i += GT) z[i] = (u32x4){0u, 0u, 0u, 0u}; }
    { float* cosT = (float*)(p.ws + WS_COS); float* sinT = (float*)(p.ws + WS_SIN);
      for (int i = gtid; i < 2056 * 128; i += GT) { const int pi = i >> 7, fi = i & 127; const int pos = pi < 2048 ? pi : 16384 + pi - 2048;
          const float inv = powf(10000.0f, -(float)fi / 128.0f); const float ang = (float)pos * inv;
          const double rev = (double)ang * 0.15915494309189533577; const float fr = (float)(rev - rint(rev));
          cosT[i] = __builtin_amdgcn_cosf(fr); sinT[i] = __builtin_amdgcn_sinf(fr); } }
    row_pass(p, 0, 0.f, nullptr, 0);
}

#define BSYNC() do { asm volatile("s_waitcnt vmcnt(0) lgkmcnt(0)" ::: "memory"); __syncthreads(); } while (0)
template <int TY> __device__ __forceinline__ void ma_even_item(const Params& p, ldsp lds, int item) {
    constexpr int DK = TY ? 128 : 64, NSEG = NTHREADS / DK, SEGL = 64 / NSEG;
    const int tid = otid(), lane = tid & 63, wave = __builtin_amdgcn_readfirstlane(tid >> 6), l15 = lane & 15, q4 = lane >> 4;
    const int bh = item >> 5, c = item & 31, b = bh >> 2, h = bh & 3, row0 = b * 2048 + c * 64;
    const int d = tid % DK, sg = tid / DK;
    LAS float* Bl = (LAS float*)lds; LAS float* SEG = (LAS float*)(lds + 32768); LAS float* LRs = (LAS float*)(lds + 36864);
    ldsp KHT = lds + 40960; ldsp VT = lds + 59392;
    const bf16_t* Pb = (const bf16_t*)(p.ws + WS_P) + (size_t)row0 * NE;
    if (TY == 0) { for (int idx = tid; idx < 1024; idx += NTHREADS) LRs[idx] = bf2f(Pb[(size_t)(idx >> 4) * NE + E_LR + (idx & 15)]); }
    stage_T<128>(VT, 72, Pb + (TY ? E_IB : E_VA) + h * 128, NE, wave, lane);
    float w2[16]; float bias = 0.f, lbv = 0.f;
    if (TY == 0) {
#pragma unroll
        for (int r = 0; r < 16; ++r) w2[r] = p.in[10][r * 256 + h * 64 + d];
        bias = p.in[11][h * 64 + d];
    } else { const float t0 = p.in[13][h * 128 + d], t1 = p.in[13][512 + h * 128 + d], t2 = p.in[13][1024 + h * 128 + d];
        const float mx = fmaxf(t0, fmaxf(t1, t2)); const float e0 = __expf(t0 - mx), e1 = __expf(t1 - mx), e2 = __expf(t2 - mx); lbv = e0 / (e0 + e1 + e2); }
    BSYNC();
    float run = 0.f;
#pragma unroll
    for (int i = 0; i < SEGL; ++i) { const int s = sg * SEGL + i; float g;
        if (TY == 0) { float x = bias;
#pragma unroll
            for (int r = 0; r < 16; ++r) x += LRs[s * 16 + r] * w2[r];
            g = logsig(x) * 0.0625f;
        } else { const float x = bf2f(Pb[(size_t)s * NE + E_FB + h * 128 + d]); const float sig = __builtin_amdgcn_rcpf(1.0f + __expf(-x)); g = __logf(lbv + (1.0f - lbv) * sig); }
        run += g; Bl[s * DK + d] = run; }
    SEG[sg * 128 + d] = run;
    BSYNC();
    float off = 0.f, tot = 0.f;
#pragma unroll
    for (int s2 = 0; s2 < NSEG; ++s2) { const float v = SEG[s2 * 128 + d]; if (s2 < sg) off += v; tot += v; }
#pragma unroll
    for (int i = 0; i < SEGL; ++i) Bl[(sg * SEGL + i) * DK + d] += off;
    BSYNC();
    const float bmid = Bl[31 * DK + d], blast = tot;
    bf16_t* QT = (bf16_t*)(p.ws + WS_QT); bf16_t* QH = (bf16_t*)(p.ws + WS_QH); bf16_t* KT = (bf16_t*)(p.ws + WS_KT);
    const int col = TY ? 256 + h * 128 + d : h * 64 + d;
#pragma unroll
    for (int i = 0; i < SEGL; ++i) { const int s = sg * SEGL + i; const float bs = Bl[s * DK + d]; float qv, kv;
        if (TY == 0) { qv = bf2f(Pb[(size_t)s * NE + E_QA + h * 64 + d]) * 0.125f; kv = bf2f(Pb[(size_t)s * NE + E_KA + h * 64 + d]); }
        else { qv = siluf(bf2f(Pb[(size_t)s * NE + E_QB + h * 128 + d])); const float xf = bf2f(Pb[(size_t)s * NE + E_FB + h * 128 + d]); kv = (1.0f - lbv) * __builtin_amdgcn_rcpf(1.0f + __expf(xf)); }
        const size_t g = (size_t)(row0 + s) * 768 + col;
        QT[g] = (bf16_t)f2bf(qv * __expf(fminf(bs - bmid, 80.f))); QH[g] = (bf16_t)f2bf(qv * __expf(bs)); KT[g] = (bf16_t)f2bf(kv * __expf(fminf(bmid - bs, 80.f)));
        *(LAS bf16_t*)(KHT + (size_t)(d * 72 + s) * 2) = (bf16_t)f2bf(kv * __expf(blast - bs)); }
    if (sg == 0) ((float*)(p.ws + WS_DEC + (TY ? DEC_HGRN : 0)))[(size_t)item * DK + d] = __expf(blast);
    BSYNC();
    f32x4 acc[DK / 16];
#pragma unroll
    for (int i = 0; i < DK / 16; ++i) acc[i] = (f32x4){0.f, 0.f, 0.f, 0.f};
#pragma unroll
    for (int ks = 0; ks < 2; ++ks) { const bf16x8 bf = ldfrag(VT, (16 * wave + l15) * 72 + 32 * ks + 8 * q4);
#pragma unroll
        for (int i = 0; i < DK / 16; ++i) acc[i] = mma16(ldfrag(KHT, (16 * i + l15) * 72 + 32 * ks + 8 * q4), bf, acc[i]); }
    bf16_t* HL = (bf16_t*)(p.ws + WS_HL + (TY ? HL_HGRN : 0)) + ((size_t)item * 128 + 16 * wave + l15) * DK;
#pragma unroll
    for (int i = 0; i < DK / 16; ++i) { u32x2 w; w.x = pk2(acc[i][0], acc[i][1]); w.y = pk2(acc[i][2], acc[i][3]); *(u32x2*)(HL + 16 * i + 4 * q4) = w; }
    BSYNC();
}

__device__ __forceinline__ void ma_ret_item(const Params& p, ldsp lds, int item) {
    const int tid = otid(), lane = tid & 63, wave = __builtin_amdgcn_readfirstlane(tid >> 6), l15 = lane & 15, q4 = lane >> 4;
    const int es = item & 3, sc = (item >> 2) & 7, bh = item >> 5, b = bh >> 2, h = bh & 3;
    ldsp KTt = lds; ldsp VTt = lds + 36864;
    const bf16_t* Pb = (const bf16_t*)(p.ws + WS_P);
    f32x4 acc[16];
#pragma unroll
    for (int i = 0; i < 16; ++i) acc[i] = (f32x4){0.f, 0.f, 0.f, 0.f};
    u32x4 kr[4], vr[2];
    { const size_t rowq = (size_t)b * 2048 + (sc * 4) * 64;
      ld_T<256>(kr, Pb + rowq * NO + O_K + h * 256, NO, wave, lane); ld_T<128>(vr, Pb + rowq * NO + O_V + h * 512 + es * 128, NO, wave, lane); }
    for (int j = 0; j < 4; ++j) { const size_t rowj = (size_t)b * 2048 + (sc * 4 + j) * 64;
        st_T<256>(KTt, 72, kr, wave, lane); st_T<128>(VTt, 72, vr, wave, lane);
        __syncthreads();
        if (j < 3) { const size_t rown = rowj + 64; ld_T<256>(kr, Pb + rown * NO + O_K + h * 256, NO, wave, lane); ld_T<128>(vr, Pb + rown * NO + O_V + h * 512 + es * 128, NO, wave, lane); }
#pragma unroll
        for (int ks = 0; ks < 2; ++ks) { const bf16x8 bf = ldfrag(VTt, (16 * wave + l15) * 72 + 32 * ks + 8 * q4);
#pragma unroll
            for (int i = 0; i < 16; ++i) acc[i] = mma16(ldfrag(KTt, (16 * i + l15) * 72 + 32 * ks + 8 * q4), bf, acc[i]); }
        __syncthreads(); }
    bf16_t* HL = (bf16_t*)(p.ws + WS_HL) + (((size_t)bh * 8 + sc) * 512 + es * 128 + 16 * wave + l15) * 256;
#pragma unroll
    for (int i = 0; i < 16; ++i) { u32x2 w; w.x = pk2(acc[i][0], acc[i][1]); w.y = pk2(acc[i][2], acc[i][3]); *(u32x2*)(HL + 16 * i + 4 * q4) = w; }
}

template <int DK, int DV, int NC, bool RET> __device__ __forceinline__ void scan_states(const bf16_t* HL, const float* DEC, bf16_t* ST, float* outp) {
    constexpr int DQ = DK / 4; constexpr int total = 32 * DV * DQ;
    const int gtid = blockIdx.x * NTHREADS + otid(), GT = gridDim.x * NTHREADS;
    for (int idx = gtid; idx < total; idx += GT) {
        const int dq = idx % DQ, e = (idx / DQ) % DV, bh = idx / (DQ * DV);
        f32x4 S = (f32x4){0.f, 0.f, 0.f, 0.f}; float c_st = 1.f, c_dec = 1.f, c_h = 1.f;
        if (RET) { const float l2g = __log2f(1.0f - exp2f(-5.0f - (float)(bh & 3))); c_st = exp2f(129.f * l2g); c_dec = exp2f(256.f * l2g); c_h = exp2f(127.f * l2g); }
#pragma unroll 8
        for (int c = 0; c < NC; ++c) { const size_t base = (((size_t)bh * NC + c) * DV + e) * DK + dq * 4;
            u32x2 w; w.x = pk2(S[0] * c_st, S[1] * c_st); w.y = pk2(S[2] * c_st, S[3] * c_st); *(u32x2*)(ST + base) = w;
            const u32x2 hw = __builtin_nontemporal_load((const u32x2*)(HL + base)); const f32x4 hl = (f32x4){bf2f(hw.x & 0xffffu), bf2f(hw.x >> 16), bf2f(hw.y & 0xffffu), bf2f(hw.y >> 16)};
            f32x4 dec; if (RET) dec = (f32x4){c_dec, c_dec, c_dec, c_dec}; else dec = *(const f32x4*)(DEC + ((size_t)bh * NC + c) * DK + dq * 4);
            S = dec * S + hl * c_h; }
#pragma unroll
        for (int j = 0; j < 4; ++j) outp[((size_t)bh * DK + dq * 4 + j) * DV + e] = S[j];
    }
}

template <int TY> __device__ __forceinline__ void mc_item(const Params& p, ldsp lds, int item) {
    constexpr int DK = TY == 0 ? 64 : (TY == 1 ? 128 : 256), DV = TY == 2 ? 512 : 128, NB = TY == 2 ? 4 : 1, ET = DV / 128, PQ = DK + 8;
    constexpr int szQ = 64 * PQ * 2, o_qh = szQ, o_kt = (TY == 2 ? 1 : 2) * szQ, o_vt = o_kt + szQ, o_pm = o_vt + DV * 144, o_red = o_pm + 64 * 144;
    static_assert(o_red + 2048 <= LDS_BYTES, "mc LDS");
    const int tid = otid(), lane = tid & 63, wave = __builtin_amdgcn_readfirstlane(tid >> 6), l15 = lane & 15, q4 = lane >> 4;
    const int bh = item >> 5, c = item & 31, b = bh >> 2, h = bh & 3, sc = c / NB, jc = c % NB, row0 = b * 2048 + c * 64;
#ifdef LDSSHIFT
    if (TY != 2) lds += LDSSHIFT;
#endif
    ldsp QX = lds, QH2 = lds + o_qh, KTs = lds + o_kt, VTs = lds + o_vt, Pm = lds + o_pm; LAS float* RED = (LAS float*)(lds + o_red);
    const bf16_t* Pb = (const bf16_t*)(p.ws + WS_P);
    constexpr int PP = TY == 2 ? NO : NE;
    const int ecol = TY ? 256 + h * 128 : h * 64;
    if (TY == 2) stage_rows<DK>(QX, PQ, Pb + (size_t)row0 * NO + O_Q + h * 256, NO, tid);
    else { stage_rows<DK>(QX, PQ, (const bf16_t*)(p.ws + WS_QT) + (size_t)row0 * 768 + ecol, 768, tid);
           stage_rows<DK>(QH2, PQ, (const bf16_t*)(p.ws + WS_QH) + (size_t)row0 * 768 + ecol, 768, tid); }
    f32x4 acc[ET][4];
#pragma unroll
    for (int ei = 0; ei < ET; ++ei)
#pragma unroll
        for (int tk = 0; tk < 4; ++tk) acc[ei][tk] = (f32x4){0.f, 0.f, 0.f, 0.f};
    const int voff = TY == 0 ? E_VA + h * 128 : (TY == 1 ? E_IB + h * 128 : O_V + h * 512);
    const int tt = wave & 3, sp = wave >> 2;
    u32x4 kr[TY == 2 ? 4 : 1], vr[TY == 2 ? 8 : 1];
    if constexpr (TY == 2) { const size_t rowq = (size_t)b * 2048 + (sc * NB) * 64;
        ld_rows<256>(kr, Pb + rowq * NO + O_K + h * 256, NO, tid); ld_T<512>(vr, Pb + rowq * NO + voff, NO, wave, lane); }
    for (int j = 0; j <= jc; ++j) { const size_t rowj = (size_t)b * 2048 + (sc * NB + j) * 64;
        if constexpr (TY == 2) { st_rows<256>(KTs, PQ, kr, tid); st_T<512>(VTs, 72, vr, wave, lane); }
        else { stage_rows<DK>(KTs, PQ, (const bf16_t*)(p.ws + WS_KT) + rowj * 768 + ecol, 768, tid);
               stage_T<DV>(VTs, 72, Pb + rowj * PP + voff, PP, wave, lane); }
        if constexpr (TY == 2) { __syncthreads(); if (j < jc) { const size_t rown = rowj + 64; ld_rows<256>(kr, Pb + rown * NO + O_K + h * 256, NO, tid); ld_T<512>(vr, Pb + rown * NO + voff, NO, wave, lane); } }
        else BSYNC();
        { f32x4 c0 = (f32x4){0.f, 0.f, 0.f, 0.f}, c1 = c0;
#pragma unroll
          for (int ks = 0; ks < DK / 32; ++ks) { const bf16x8 bq = ldfrag(QX, (16 * tt + l15) * PQ + 32 * ks + 8 * q4);
              c0 = mma16(ldfrag(KTs, (16 * (2 * sp) + l15) * PQ + 32 * ks + 8 * q4), bq, c0);
              c1 = mma16(ldfrag(KTs, (16 * (2 * sp + 1) + l15) * PQ + 32 * ks + 8 * q4), bq, c1); }
          const int t = 16 * tt + l15;
          const int tl = (j == jc) ? t : 4096;
#pragma unroll
          for (int jj = 0; jj < 4; ++jj) { if (32 * sp + 4 * q4 + jj > tl) c0[jj] = 0.f; if (32 * sp + 16 + 4 * q4 + jj > tl) c1[jj] = 0.f; }
          u32x2 w; w.x = pk2(c0[0], c0[1]); w.y = pk2(c0[2], c0[3]); *(LAS u32x2*)(Pm + (size_t)(t * 72 + 32 * sp + 4 * q4) * 2) = w;
          w.x = pk2(c1[0], c1[1]); w.y = pk2(c1[2], c1[3]); *(LAS u32x2*)(Pm + (size_t)(t * 72 + 32 * sp + 16 + 4 * q4) * 2) = w; }
        if constexpr (TY == 2) __syncthreads(); else BSYNC();
#pragma unroll
        for (int ks = 0; ks < 2; ++ks) { bf16x8 pb[4];
#pragma unroll
            for (int tk = 0; tk < 4; ++tk) pb[tk] = ldfrag(Pm, (16 * tk + l15) * 72 + 32 * ks + 8 * q4);
#pragma unroll
            for (int ei = 0; ei < ET; ++ei) { const bf16x8 va = ldfrag(VTs, (16 * (wave * ET + ei) + l15) * 72 + 32 * ks + 8 * q4);
#pragma unroll
                for (int tk = 0; tk < 4; ++tk) acc[ei][tk] = mma16(va, pb[tk], acc[ei][tk]); } }
        if constexpr (TY == 2) __syncthreads(); else BSYNC(); }
    if ((TY == 2 ? sc : c) != 0) { const bf16_t* STp = (TY == 2) ? (const bf16_t*)(p.ws + WS_ST) + ((size_t)bh * 8 + sc) * 512 * 256
                                    : (const bf16_t*)(p.ws + WS_ST + (TY ? ST_HGRN : 0)) + ((size_t)bh * 32 + c) * 128 * DK;
      ldsp QS = (TY == 2) ? QX : QH2;
      bf16x8 sa[ET], sn[ET];
#pragma unroll
      for (int ei = 0; ei < ET; ++ei) sa[ei] = *(const bf16x8*)(STp + (size_t)(16 * (wave * ET + ei) + l15) * DK + 8 * q4);
#pragma unroll 1
      for (int ks = 0; ks < DK / 32; ++ks) { bf16x8 qb[4];
          const int kn = (ks + 1 < DK / 32) ? ks + 1 : ks;
#pragma unroll
          for (int ei = 0; ei < ET; ++ei) sn[ei] = *(const bf16x8*)(STp + (size_t)(16 * (wave * ET + ei) + l15) * DK + 32 * kn + 8 * q4);
#pragma unroll
          for (int tk = 0; tk < 4; ++tk) qb[tk] = ldfrag(QS, (16 * tk + l15) * PQ + 32 * ks + 8 * q4);
#pragma unroll
          for (int ei = 0; ei < ET; ++ei) {
#pragma unroll
              for (int tk = 0; tk < 4; ++tk) acc[ei][tk] = mma16(sa[ei], qb[tk], acc[ei][tk]); }
#pragma unroll
          for (int ei = 0; ei < ET; ++ei) sa[ei] = sn[ei]; } }
    if (TY == 2 && (DBGSKIP & 4)) {
#pragma unroll
        for (int ei = 0; ei < ET; ++ei)
#pragma unroll
            for (int tk = 0; tk < 4; ++tk)
#pragma unroll
                for (int jj = 0; jj < 4; ++jj) acc[ei][tk][jj] = (float)((16 * (wave * ET + ei) + 4 * q4 + jj + 3 * (16 * tk + l15) + row0) & 15) - 7.5f;
    }
    float rstd[4];
#pragma unroll
    for (int tk = 0; tk < 4; ++tk) { float s = 0.f;
#pragma unroll
        for (int ei = 0; ei < ET; ++ei) { const f32x4 v = acc[ei][tk]; s += (v[0] * v[0] + v[1] * v[1]) + (v[2] * v[2] + v[3] * v[3]); }
        s += __shfl_xor(s, 16); s += __shfl_xor(s, 32);
        if (q4 == 0) RED[wave * 64 + 16 * tk + l15] = s; }
    BSYNC();
#pragma unroll
    for (int tk = 0; tk < 4; ++tk) { float s = 0.f;
#pragma unroll
        for (int w = 0; w < 8; ++w) s += RED[w * 64 + 16 * tk + l15];
        rstd[tk] = rsqrtf(s * (1.0f / DV) + EPS); }
    const float* nwp = TY == 0 ? p.in[12] : (TY == 1 ? p.in[14] : p.in[17]);
    const int goff = TY == 0 ? E_RA + h * 128 : (TY == 1 ? E_GB + h * 128 : O_G + h * 512);
    constexpr int LDY = TY == 2 ? 2048 : 1024; const int ycol = TY == 0 ? h * 128 : (TY == 1 ? 512 + h * 128 : h * 512);
    bf16_t* Y = (bf16_t*)(p.ws + WS_Y);
#pragma unroll
    for (int ei = 0; ei < ET; ++ei) { const int e0 = 16 * (wave * ET + ei) + 4 * q4; const f32x4 w4 = *(const f32x4*)(nwp + e0);
#pragma unroll
        for (int tk = 0; tk < 4; ++tk) { const size_t row = (size_t)row0 + 16 * tk + l15;
            const u32x2 gw = *(const u32x2*)(Pb + row * PP + goff + e0);
            const float g0 = bf2f(gw.x & 0xffffu), g1 = bf2f(gw.x >> 16), g2 = bf2f(gw.y & 0xffffu), g3 = bf2f(gw.y >> 16);
            const f32x4 v = acc[ei][tk] * rstd[tk] * w4;
            float y0 = v[0] * siluf(g0), y1 = v[1] * siluf(g1), y2 = v[2] * siluf(g2), y3 = v[3] * siluf(g3);
#ifdef NANFIX
            if (!(fabsf(y0) < 1e30f)) y0 = 0.f; if (!(fabsf(y1) < 1e30f)) y1 = 0.f; if (!(fabsf(y2) < 1e30f)) y2 = 0.f; if (!(fabsf(y3) < 1e30f)) y3 = 0.f;
#endif
            u32x2 o; o.x = pk2(y0, y1); o.y = pk2(y2, y3);
            *(u32x2*)(Y + row * LDY + ycol + e0) = o; } }
    BSYNC();
}

template <int TY> __device__ __forceinline__ void sample_item(const Params& p, ldsp lds, int item) {
    constexpr int DK = TY == 0 ? 64 : (TY == 1 ? 128 : 256), DV = TY == 2 ? 512 : 128, E4 = DV / 4, NG = NTHREADS / E4, PP = TY == 2 ? NO : NE;
    const int tid = otid(), lane = tid & 63, wave = __builtin_amdgcn_readfirstlane(tid >> 6);
    const int b = item >> 2, h = item & 3, r0 = MP + b * 8;
    LAS float* QK = (LAS float*)lds; LAS float* Bs = (LAS float*)(lds + 16384); LAS float* QR = (LAS float*)(lds + 24576); LAS float* KR = (LAS float*)(lds + 32768);
    LAS float* DECs = (LAS float*)(lds + 40960); LAS float* As = (LAS float*)(lds + 41984); LAS float* Vs = (LAS float*)(lds + 42240); LAS float* OP = (LAS float*)(lds + 58624);
    static_assert(58624 + 65536 <= LDS_BYTES, "sample LDS");
    const bf16_t* Pb = (const bf16_t*)(p.ws + WS_P) + (size_t)r0 * PP;
    const int voff = TY == 0 ? E_VA + h * 128 : (TY == 1 ? E_IB + h * 128 : O_V + h * 512);
    for (int idx = tid; idx < 8 * DV; idx += NTHREADS) { const int t = idx / DV, e = idx % DV; Vs[idx] = bf2f(Pb[(size_t)t * PP + voff + e]); }
    if (tid < DK) { const int d = tid;
        float w2[16]; float bias = 0.f, lbv = 0.f, lng = 0.f;
        if (TY == 0) {
#pragma unroll
            for (int r = 0; r < 16; ++r) w2[r] = p.in[10][r * 256 + h * 64 + d];
            bias = p.in[11][h * 64 + d];
        } else if (TY == 1) { const float t0 = p.in[13][h * 128 + d], t1 = p.in[13][512 + h * 128 + d], t2 = p.in[13][1024 + h * 128 + d];
            const float mx = fmaxf(t0, fmaxf(t1, t2)); const float e0 = __expf(t0 - mx), e1 = __expf(t1 - mx), e2 = __expf(t2 - mx); lbv = e0 / (e0 + e1 + e2);
        } else lng = __logf(1.0f - exp2f(-5.0f - (float)h));
        float run = 0.f; float bt[8], qv[8], kv[8];
#pragma unroll
        for (int t = 0; t < 8; ++t) { float g;
            if (TY == 0) { float x = bias;
#pragma unroll
                for (int r = 0; r < 16; ++r) x += bf2f(Pb[(size_t)t * NE + E_LR + r]) * w2[r];
                g = logsig(x) * 0.0625f; qv[t] = bf2f(Pb[(size_t)t * NE + E_QA + h * 64 + d]) * 0.125f; kv[t] = bf2f(Pb[(size_t)t * NE + E_KA + h * 64 + d]);
            } else if (TY == 1) { const float xf = bf2f(Pb[(size_t)t * NE + E_FB + h * 128 + d]); const float sig = __builtin_amdgcn_rcpf(1.0f + __expf(-xf));
                g = __logf(lbv + (1.0f - lbv) * sig); kv[t] = (1.0f - lbv) * __builtin_amdgcn_rcpf(1.0f + __expf(xf)); qv[t] = siluf(bf2f(Pb[(size_t)t * NE + E_QB + h * 128 + d]));
            } else { g = lng; qv[t] = bf2f(Pb[(size_t)t * NO + O_Q + h * 256 + d]); kv[t] = bf2f(Pb[(size_t)t * NO + O_K + h * 256 + d]); }
            run += g; bt[t] = run; }
#pragma unroll
        for (int t = 0; t < 8; ++t) { Bs[t * DK + d] = bt[t]; QR[t * DK + d] = qv[t]; KR[t * DK + d] = kv[t];
            QK[d * 16 + t] = qv[t] * __expf(bt[t]); QK[d * 16 + 8 + t] = kv[t] * __expf(run - bt[t]); }
        DECs[d] = __expf(run); }
    BSYNC();
    { const int pq = tid & 63, part = tid >> 6, t = pq >> 3, s = pq & 7;
      float a = 0.f;
      if (s <= t) { for (int d = part; d < DK; d += 8) a += QR[t * DK + d] * KR[s * DK + d] * __expf(Bs[t * DK + d] - Bs[s * DK + d]); }
      OP[part * 64 + pq] = a; }
    BSYNC();
    if (tid < 64) { float a = 0.f;
#pragma unroll
        for (int q = 0; q < 8; ++q) a += OP[q * 64 + tid];
        As[tid] = a; }
    BSYNC();
    const int e4 = tid % E4, dg = tid / E4;
    f32x4 v[8], o[8];
#pragma unroll
    for (int t = 0; t < 8; ++t) { v[t] = *(const LAS f32x4*)(Vs + t * DV + e4 * 4); o[t] = (f32x4){0.f, 0.f, 0.f, 0.f}; }
    const float* S0 = (TY == 0 ? p.in[2] : (TY == 1 ? p.in[3] : p.in[4])) + (size_t)item * DK * DV;
    float* S1 = p.out + (TY == 0 ? OUT_GLA_S : (TY == 1 ? OUT_HGRN_S : OUT_RET_S)) + (size_t)item * DK * DV;
#pragma unroll 8
    for (int d = dg; d < DK; d += NG) { const f32x4 s0 = __builtin_nontemporal_load((const f32x4*)(S0 + (size_t)d * DV + e4 * 4));
        const f32x4 qa = *(const LAS f32x4*)(QK + d * 16), qb = *(const LAS f32x4*)(QK + d * 16 + 4), ka = *(const LAS f32x4*)(QK + d * 16 + 8), kb = *(const LAS f32x4*)(QK + d * 16 + 12);
        const float dc = DECs[d];
        o[0] += s0 * qa[0]; o[1] += s0 * qa[1]; o[2] += s0 * qa[2]; o[3] += s0 * qa[3]; o[4] += s0 * qb[0]; o[5] += s0 * qb[1]; o[6] += s0 * qb[2]; o[7] += s0 * qb[3];
        f32x4 sn = s0 * dc; sn += v[0] * ka[0]; sn += v[1] * ka[1]; sn += v[2] * ka[2]; sn += v[3] * ka[3]; sn += v[4] * kb[0]; sn += v[5] * kb[1]; sn += v[6] * kb[2]; sn += v[7] * kb[3];
        __builtin_nontemporal_store(sn, (f32x4*)(S1 + (size_t)d * DV + e4 * 4)); }
#pragma unroll
    for (int t = 0; t < 8; ++t) *(LAS f32x4*)(OP + (dg * 8 + t) * DV + e4 * 4) = o[t];
    BSYNC();
    { const int t = wave; float val[DV / 64]; float ssq = 0.f;
#pragma unroll
      for (int i = 0; i < DV / 64; ++i) { const int e = lane + 64 * i; float a = 0.f;
          for (int g = 0; g < NG; ++g) a += OP[(g * 8 + t) * DV + e];
          for (int s = 0; s <= t; ++s) a += As[t * 8 + s] * Vs[s * DV + e];
          val[i] = a; ssq += a * a; }
      ssq = wave_sum(ssq); const float rstd = rsqrtf(ssq * (1.0f / DV) + EPS);
      const float* nwp = TY == 0 ? p.in[12] : (TY == 1 ? p.in[14] : p.in[17]);
      const int goff = TY == 0 ? E_RA + h * 128 : (TY == 1 ? E_GB + h * 128 : O_G + h * 512);
      constexpr int LDY = TY == 2 ? 2048 : 1024; const int ycol = TY == 0 ? h * 128 : (TY == 1 ? 512 + h * 128 : h * 512);
      bf16_t* Y = (bf16_t*)(p.ws + WS_Y) + (size_t)(r0 + t) * LDY + ycol;
#pragma unroll
      for (int i = 0; i < DV / 64; ++i) { const int e = lane + 64 * i; const float g = bf2f(Pb[(size_t)t * PP + goff + e]);
          Y[e] = (bf16_t)f2bf(val[i] * rstd * nwp[e] * siluf(g)); } }
    BSYNC();
}

#define XB_TMO      128
#define XB_XCNT(j)  (256  + 64 * (j))
#define XB_XSUB(j)  (1280 + 64 * (j))
#define XB_XGEN(j)  (2304 + 64 * (j))
#define XB_TOP      3328
#define XB_TOPGEN   3392
#define XCD_BAR_WORDS 3456
#define XB_SPIN_CAP (1u << 18)

__device__ __forceinline__ unsigned xb_ld(unsigned* p)              { return __hip_atomic_load(p, __ATOMIC_RELAXED, __HIP_MEMORY_SCOPE_AGENT); }
__device__ __forceinline__ unsigned xb_add(unsigned* p, unsigned v) { return __hip_atomic_fetch_add(p, v, __ATOMIC_RELAXED, __HIP_MEMORY_SCOPE_AGENT); }
__device__ __forceinline__ unsigned xb_xcc_id() { return (unsigned)__builtin_amdgcn_s_getreg((3 << 11) | 20) & 0xFu; }
#define XB_SPIN(cond, bar) do { unsigned _sp = 0; while (cond) { __builtin_amdgcn_s_sleep(1); \
    if ((++_sp & 255u) == 0u) { if (xb_ld(&(bar)[XB_TMO])) break; if (_sp > XB_SPIN_CAP) { atomicAdd(&(bar)[XB_TMO], 1u); break; } } } } while (0)
struct XcdBarrier {
    unsigned* bar; unsigned x;
    volatile LAS unsigned* st;
};

__device__ __forceinline__ XcdBarrier xcd_barrier_post(unsigned* bar, volatile LAS unsigned* st) {
    XcdBarrier b; b.bar = bar; b.x = xb_xcc_id(); b.st = st;
    if (threadIdx.x == 0) (void)xb_add(&bar[XB_XCNT(b.x)], 1u);
    return b;
}
__device__ __forceinline__ void xcd_barrier_complete(unsigned* bar, unsigned x, unsigned& nloc, unsigned& nx) {
    const unsigned G = gridDim.x * gridDim.y * gridDim.z;
    unsigned sum, cnt, mine, sp = 0u;
    for (;;) {
        sum = 0u; cnt = 0u; mine = 0u;
#pragma unroll
        for (unsigned j = 0; j < 16; ++j) { const unsigned c = xb_ld(&bar[XB_XCNT(j)]); sum += c; cnt += (c > 0u) ? 1u : 0u; mine = (j == x) ? c : mine; }
        if (sum == G) break;
        __builtin_amdgcn_s_sleep(1);
        if ((++sp & 255u) == 0u) { if (xb_ld(&bar[XB_TMO])) break; if (sp > XB_SPIN_CAP) { atomicAdd(&bar[XB_TMO], 1u); break; } }
    }
    nloc = mine > 0u ? mine : 1u; nx = cnt > 0u ? cnt : 1u;
}

__device__ __forceinline__ void xcd_barrier(const XcdBarrier& b) {
    asm volatile("s_waitcnt vmcnt(0)" ::: "memory");
    __syncthreads();
    if (threadIdx.x == 0) {
        unsigned* bar = b.bar;
        __builtin_amdgcn_s_waitcnt(0);
        unsigned nloc = b.st[0], nx = b.st[1];
        if (nloc == 0u) { xcd_barrier_complete(bar, b.x, nloc, nx); b.st[0] = nloc; b.st[1] = nx; }
        const unsigned old = xb_add(&bar[XB_XSUB(b.x)], 1u);
        const unsigned gen = old / nloc;
        if (old + 1u == (gen + 1u) * nloc) {
            __builtin_amdgcn_fence(__ATOMIC_RELEASE, "agent");
            asm volatile("s_waitcnt vmcnt(0)" ::: "memory");
            const unsigned og = xb_add(&bar[XB_TOP], 1u);
            const unsigned tg = og / nx;
            if (og + 1u == (tg + 1u) * nx) xb_add(&bar[XB_TOPGEN], 1u);
            else XB_SPIN(xb_ld(&bar[XB_TOPGEN]) == tg, bar);
            __builtin_amdgcn_fence(__ATOMIC_ACQUIRE, "agent");
            xb_add(&bar[XB_XGEN(b.x)], 1u);
            asm volatile("s_waitcnt vmcnt(0)" ::: "memory");
        } else {
            XB_SPIN(xb_ld(&bar[XB_XGEN(b.x)]) == gen, bar);
            __builtin_amdgcn_fence(__ATOMIC_ACQUIRE, "agent");
            asm volatile("s_waitcnt vmcnt(0)" ::: "memory");
        }
    }
    __syncthreads();
}

__device__ __forceinline__ unsigned char* ows(const Params& p) { unsigned char* w = p.ws; asm volatile("" : "+s"(w)); return w; }
__device__ __forceinline__ void gsync(cg::grid_group& grid) {
    asm volatile("s_waitcnt vmcnt(0) lgkmcnt(0)" ::: "memory");
    grid.sync();
    __builtin_amdgcn_fence(__ATOMIC_ACQUIRE, "agent");
    asm volatile("s_waitcnt vmcnt(0)" ::: "memory");
}
__global__ void __launch_bounds__(NTHREADS, 2) fwd_megakernel(Params p) {
    extern __shared__ __attribute__((aligned(16))) unsigned char lds_raw[];
    cg::grid_group grid = cg::this_grid();
    ldsp lds = (ldsp)lds_raw;
    const int G = gridDim.x, bid = blockIdx.x;
    volatile LAS unsigned* xst = (volatile LAS unsigned*)(lds + LDS_BYTES - 16);
    if (threadIdx.x == 0) { xst[0] = 0u; xst[1] = 0u; xst[2] = 0u; xst[3] = 0u; }
    __syncthreads();
    (void)xcd_barrier_post((unsigned*)(p.ws + WS_BAR), xst);
#define XSYNC() do { XcdBarrier xb_; xb_.bar = (unsigned*)(p.ws + WS_BAR); xb_.x = xb_xcc_id(); xb_.st = (volatile LAS unsigned*)(lds + LDS_BYTES - 16); xcd_barrier(xb_); } while (0)

    prologue(p, lds);
#if REP_P0 > 1
    prologue(p, lds);
#endif
    XSYNC();
#pragma unroll 1
    for (int f = 0; f < 4; ++f) { const int l = f >> 1, j = f & 1;
        { unsigned char* ws = ows(p); pg8::Gemm g{(const bf16_t*)(ws + WS_XB), (const bf16_t*)(ws + WS_WUP + f * SZ_WUP), M, NUP, D, D}; pg8::StaticOrder S; S.init(M, NUP, G, bid, TREP_UP);
          pg8::EpiSwiGLU E{(bf16_t*)(ws + WS_ACT), (const float*)(ws + WS_RS)}; pg8::gemm_phase<pg8::EpiSwiGLU, pg8::StaticOrder, true, true>(lds, g, S, E);
#if REP_UP > 1
                  pg8::gemm_phase<pg8::EpiSwiGLU, pg8::StaticOrder, true, true>(lds, g, S, E);
#endif
                }
        XSYNC();
        { unsigned char* ws = ows(p); pg8::Gemm g{(const bf16_t*)(ws + WS_ACT), (const bf16_t*)(ws + WS_WDN + f * SZ_WDN), MP, D, FF, FF}; pg8::StaticOrder S; S.init(MP, D, G, bid, TREP_DN);
          pg8::EpiB16 E{(bf16_t*)(ws + WS_F)}; pg8::gemm_phase<pg8::EpiB16, pg8::StaticOrder, true, true>(lds, g, S, E); }
        { unsigned char* ws = ows(p); pg8::Gemm g{(const bf16_t*)(ws + WS_ACT), (const bf16_t*)(ws + WS_WDN + f * SZ_WDN), M, D, 256, FF}; pg8::SplitOrder S; S.init(11, G, bid);
          pg8::EpiPart E{(float*)(ws + WS_PART)}; pg8::gemm_phase<pg8::EpiPart, pg8::SplitOrder, true, true>(lds, g, S, E); }
        XSYNC();
        if (PHMASK & 8) row_pass(p, f == 3 ? 2 : 1, 0.5f, p.in[5] + (l * 6 + (j ? 5 : 1)) * D, 11);
        if (f == 3) { if (p.ws == nullptr) gsync(grid);     break; }
        XSYNC();
        if (j == 0) {
            if (l == 0) {
                { unsigned char* ws = ows(p); pg8::Gemm g{(const bf16_t*)(ws + WS_XB), (const bf16_t*)(ws + WS_WINE), M, NE, D, D}; pg8::StaticOrder S; S.init(M, NE, G, bid, TREP_IN);
                  pg8::EpiScale E{(bf16_t*)(ws + WS_P), NE, (const float*)(ws + WS_RS)}; pg8::gemm_phase<pg8::EpiScale, pg8::StaticOrder, true, true>(lds, g, S, E);
#if REP_G > 1
                  pg8::gemm_phase<pg8::EpiScale, pg8::StaticOrder, true, true>(lds, g, S, E);
#endif
                }
                XSYNC();
                for (int it = bid; it < 1024; it += G) { if (it < 512) sample_item<0>(p, lds, it); else sample_item<1>(p, lds, it - 512); }
                if (G == 256) { for (int k = 0; k < 8; ++k) { const int item = (((bid & 7) * 4 + (k & 3)) << 5) + (bid >> 3); if (k < 4) ma_even_item<0>(p, lds, item); else ma_even_item<1>(p, lds, item); } }
                else for (int it = bid; it < 2048; it += G) { if (it < 1024) ma_even_item<0>(p, lds, it); else ma_even_item<1>(p, lds, it - 1024); }
#if REP_ME > 1
                if (G == 256) { for (int k = 0; k < 8; ++k) { const int item = (((bid & 7) * 4 + (k & 3)) << 5) + (bid >> 3); if (k < 4) ma_even_item<0>(p, lds, item); else ma_even_item<1>(p, lds, item); } }
                else for (int it = bid; it < 2048; it += G) { if (it < 1024) ma_even_item<0>(p, lds, it); else ma_even_item<1>(p, lds, it - 1024); }
#endif
                XSYNC();
                scan_states<64, 128, 32, false>((const bf16_t*)(p.ws + WS_HL), (const float*)(p.ws + WS_DEC), (bf16_t*)(p.ws + WS_ST), p.out + OUT_GLA_P);
#if REP_ME > 1
                scan_states<64, 128, 32, false>((const bf16_t*)(p.ws + WS_HL), (const float*)(p.ws + WS_DEC), (bf16_t*)(p.ws + WS_ST), p.out + OUT_GLA_P);
#endif
                scan_states<128, 128, 32, false>((const bf16_t*)(p.ws + WS_HL + HL_HGRN), (const float*)(p.ws + WS_DEC + DEC_HGRN), (bf16_t*)(p.ws + WS_ST + ST_HGRN), p.out + OUT_HGRN_P);
#if REP_ME > 1
                scan_states<128, 128, 32, false>((const bf16_t*)(p.ws + WS_HL + HL_HGRN), (const float*)(p.ws + WS_DEC + DEC_HGRN), (bf16_t*)(p.ws + WS_ST + ST_HGRN), p.out + OUT_HGRN_P);
#endif
                XSYNC();
                if (G == 256) { for (int k = 0; k < 8; ++k) { const int item = (((bid & 7) * 4 + (k & 3)) << 5) + (bid >> 3); if (k < 4) mc_item<0>(p, lds, item); else mc_item<1>(p, lds, item); } }
                else for (int it = bid; it < 2048; it += G) { if (it < 1024) mc_item<0>(p, lds, it); else mc_item<1>(p, lds, it - 1024); }
#if REP_ME > 1
                if (G == 256) { for (int k = 0; k < 8; ++k) { const int item = (((bid & 7) * 4 + (k & 3)) << 5) + (bid >> 3); if (k < 4) mc_item<0>(p, lds, item); else mc_item<1>(p, lds, item); } }
                else for (int it = bid; it < 2048; it += G) { if (it < 1024) mc_item<0>(p, lds, it); else mc_item<1>(p, lds, it - 1024); }
#endif
            } else {
                { unsigned char* ws = ows(p); pg8::Gemm g{(const bf16_t*)(ws + WS_XB), (const bf16_t*)(ws + WS_WINO), M, NO, D, D}; pg8::StaticOrder S; S.init(M, NO, G, bid, TREP_IN);
                  pg8::EpiRet E{(bf16_t*)(ws + WS_P), (const float*)(ws + WS_RS), (const float*)(ws + WS_COS), (const float*)(ws + WS_SIN)}; pg8::gemm_phase<pg8::EpiRet, pg8::StaticOrder, true, true>(lds, g, S, E);
#if REP_G > 1
                  pg8::gemm_phase<pg8::EpiRet, pg8::StaticOrder, true, true>(lds, g, S, E);
#endif
                }
                XSYNC();
                for (int it = bid; it < 512; it += G) sample_item<2>(p, lds, it);
                if (G == 256) { const int xq = bid & 7, yq = bid >> 3;
                    for (int k = 0; k < 4; ++k) { const int u = k * 8 + (yq >> 2); const int q = (xq * 4 + (u >> 3)) * 8 + (u & 7); ma_ret_item(p, lds, q * 4 + (yq & 3)); } }
                else for (int it = bid; it < 1024; it += G) ma_ret_item(p, lds, it);
#if REP_OA > 1
                if (G == 256) { const int xq = bid & 7, yq = bid >> 3;
                    for (int k = 0; k < 4; ++k) { const int u = k * 8 + (yq >> 2); const int q = (xq * 4 + (u >> 3)) * 8 + (u & 7); ma_ret_item(p, lds, q * 4 + (yq & 3)); } }
                else for (int it = bid; it < 1024; it += G) ma_ret_item(p, lds, it);
#endif
                XSYNC();
                scan_states<256, 512, 8, true>((const bf16_t*)(p.ws + WS_HL), nullptr, (bf16_t*)(p.ws + WS_ST), p.out + OUT_RET_P);
#if REP_OB > 1
                scan_states<256, 512, 8, true>((const bf16_t*)(p.ws + WS_HL), nullptr, (bf16_t*)(p.ws + WS_ST), p.out + OUT_RET_P);
#endif
                XSYNC();
                if (G == 256) { const int xq = bid & 7, yq = bid >> 3;
                    for (int k = 0; k < 4; ++k) { const int u = k * 8 + (yq >> 2); const int q = (xq * 4 + (u >> 3)) * 8 + (u & 7), jcq = ((yq & 3) + k) & 3; mc_item<2>(p, lds, (q >> 3) * 32 + (q & 7) * 4 + jcq); } }
                else for (int it = bid; it < 1024; it += G) mc_item<2>(p, lds, (it & ~31) | (((it & 31) + (it >> 8)) & 31));
#if REP_OC > 1
                if (G == 256) { const int xq = bid & 7, yq = bid >> 3;
                    for (int k = 0; k < 4; ++k) { const int u = k * 8 + (yq >> 2); const int q = (xq * 4 + (u >> 3)) * 8 + (u & 7), jcq = ((yq & 3) + k) & 3; mc_item<2>(p, lds, (q >> 3) * 32 + (q & 7) * 4 + jcq); } }
                else for (int it = bid; it < 1024; it += G) mc_item<2>(p, lds, (it & ~31) | (((it & 31) + (it >> 8)) & 31));
#endif
            }
            XSYNC();
            { unsigned char* ws = ows(p); const int KO = l == 0 ? 1024 : 2048; pg8::Gemm g{(const bf16_t*)(ws + WS_Y), (const bf16_t*)(ws + (l == 0 ? WS_WOUTE : WS_WOUTO)), MP, D, KO, KO}; pg8::StaticOrder S; S.init(MP, D, G, bid);
              pg8::EpiB16 E{(bf16_t*)(ws + WS_F)}; pg8::gemm_phase<pg8::EpiB16, pg8::StaticOrder, true, true>(lds, g, S, E); }
            { unsigned char* ws = ows(p); const int KO = l == 0 ? 1024 : 2048; pg8::Gemm g{(const bf16_t*)(ws + WS_Y), (const bf16_t*)(ws + (l == 0 ? WS_WOUTE : WS_WOUTO)), M, D, 256, KO}; pg8::SplitOrder S; S.init(KO / 256, G, bid);
              pg8::EpiPart E{(float*)(ws + WS_PART)}; pg8::gemm_phase<pg8::EpiPart, pg8::SplitOrder, true, true>(lds, g, S, E); }
            XSYNC();
            if (PHMASK & 32768) row_pass(p, 1, 1.0f, p.in[5] + (l * 6 + 3) * D, l == 0 ? 4 : 8);
            XSYNC();
        }
    }
}

extern "C" void kernel_launch(void* const* d_in, const int* in_sizes, int n_in, void* d_out, int out_size, void* d_ws, size_t ws_size, hipStream_t stream) {
    static int grid = 0;
    if (grid == 0) {
        if (n_in != 19 || ws_size < WS_END) { fprintf(stderr, "kernel_launch: unexpected n_in %d / ws %zu (need %zu)\n", n_in, ws_size, (size_t)WS_END); grid = -1; return; }
        int dev = 0, cus = 0, per_cu = 0;
        (void)hipGetDevice(&dev); (void)hipDeviceGetAttribute(&cus, hipDeviceAttributeMultiprocessorCount, dev);
        if (hipFuncSetAttribute((const void*)fwd_megakernel, hipFuncAttributeMaxDynamicSharedMemorySize, LDS_BYTES) != hipSuccess) { fprintf(stderr, "kernel_launch: hipFuncSetAttribute failed\n"); grid = -1; return; }
        if (hipOccupancyMaxActiveBlocksPerMultiprocessor(&per_cu, (const void*)fwd_megakernel, NTHREADS, LDS_BYTES) != hipSuccess || per_cu < 1) { fprintf(stderr, "kernel_launch: occupancy query says %d\n", per_cu); per_cu = 1; }
        (void)hipGetLastError();
        grid = cus * per_cu;
    }
    if (grid < 0) return;
    Params p{};
    for (int i = 0; i < 19; ++i) p.in[i] = (const float*)d_in[i];
    p.out = (float*)d_out; p.ws = (unsigned char*)d_ws;
    if (hipMemsetAsync((char*)d_ws + WS_BAR, 0, 16384, stream) != hipSuccess) { fprintf(stderr, "kernel_launch: memset of barrier words failed\n"); return; }
    void* args[] = {&p};
    hipError_t e = hipLaunchCooperativeKernel((const void*)fwd_megakernel, dim3(grid), dim3(NTHREADS), args, LDS_BYTES, stream);
    if (e != hipSuccess) fprintf(stderr, "cooperative launch failed: %s (grid %d)\n", hipGetErrorString(e), grid);
}
```

```cpp
#include <hip/hip_runtime.h>
#include <hip/hip_cooperative_groups.h>
#include <cstdio>
#include <cstdint>
namespace cg = cooperative_groups;
__device__ __forceinline__ int otid() { int t = threadIdx.x; asm volatile("" : "+v"(t)); return t; }

namespace pg8 {
#define PG8_LAS __attribute__((address_space(3)))
typedef unsigned short bf16_t;
typedef short bf16x8 __attribute__((ext_vector_type(8)));
typedef float f32x4 __attribute__((ext_vector_type(4)));
typedef unsigned u32x4 __attribute__((ext_vector_type(4)));
constexpr int BM = 256, BK = 64, HALF = 128, HTB = HALF * BK * 2  , STAGE_BYTES = 8 * HTB, NXCD = 8, WGM = 8;

__host__ __device__ __forceinline__ int lds_byte(int r, int c) { const int st = (r >> 4) * 2 + (c >> 5), rr = r & 15, cc = c & 31, ob = rr * 64 + cc * 2; return st * 1024 + (ob ^ (((ob >> 9) & 1) << 5)); }
__host__ __device__ __forceinline__ void stage_rc(int b, int& R, int& C) { const int st = b / 1024, sb = b % 1024, swz = sb ^ (((sb >> 9) & 1) << 5); R = (st >> 1) * 16 + swz / 64; C = (st & 1) * 32 + (swz % 64) / 2; }
__host__ __device__ __forceinline__ int perm32(int rho) { const int n = rho >> 4, i = rho & 15; return 8 * (i >> 2) + 4 * n + (i & 3); }

struct Unit { int pm, pn, ks; };
struct Gemm { const bf16_t* A; const bf16_t* Bt; int M, N, K, ld; };

struct StaticOrder {
    int nM, nN, nwg, G, c;
    int rep;
    __host__ __device__ void init(int M, int N, int G_, int c_, int rep_ = 1) { nM = M / BM; nN = N / BM; nwg = nM * nN; G = G_; c = c_; rep = rep_; }
    __host__ __device__ bool next(int i, Unit& u) const {
        long L = (long)i * G + c; if (L >= (long)nwg * rep) return false; if (L >= nwg) L -= nwg;
        int wgid = (int)L; { const int q = nwg / NXCD, r = nwg % NXCD, xcd = wgid % NXCD, off = wgid / NXCD; wgid = (xcd < r ? xcd * (q + 1) : r * (q + 1) + (xcd - r) * q) + off; }
        const int nig = WGM * nN, gid = wgid / nig, fm = gid * WGM, gsz = (nM - fm) < WGM ? (nM - fm) : WGM;
        u.pm = fm + ((wgid % nig) % gsz); u.pn = (wgid % nig) / gsz; u.ks = 0; return true;
    }
    __device__ __forceinline__ void a_ready(const Unit&) const {}
    __device__ __forceinline__ void done(const Unit&) const {}
};

__device__ __forceinline__ unsigned cvt_pk_bf16(float lo, float hi) { unsigned r; asm volatile("v_cvt_pk_bf16_f32 %0, %1, %2" : "=v"(r) : "v"(lo), "v"(hi)); return r; }
__device__ __forceinline__ float silu_f(float x) { return x * __builtin_amdgcn_rcpf(1.0f + __expf(-x)); }
constexpr int MPROMPT = 16384;

struct EpiSwiGLU { static constexpr bool PERM = true, AFTER_DRAIN = false;
    bf16_t* O; const float* rs;
    __device__ __forceinline__ void operator()(const f32x4 (&acc)[2][2][4][2], const Unit& u, int wr, int wc, int fr, int fq) const {
        const int row0 = u.pm * BM + wr * 64 + fr, col0 = u.pn * HALF + wc * 32 + 8 * fq;
#pragma unroll
        for (int ai = 0; ai < 2; ++ai)
#pragma unroll
            for (int m = 0; m < 4; ++m) { const int row = row0 + ai * HALF + m * 16; const float s = rs[row];
                const f32x4 g0 = acc[ai][0][m][0] * s, g1 = acc[ai][0][m][1] * s, u0 = acc[ai][1][m][0] * s, u1 = acc[ai][1][m][1] * s;
                u32x4 w;
                w.x = cvt_pk_bf16(silu_f(g0[0]) * u0[0], silu_f(g0[1]) * u0[1]); w.y = cvt_pk_bf16(silu_f(g0[2]) * u0[2], silu_f(g0[3]) * u0[3]);
                w.z = cvt_pk_bf16(silu_f(g1[0]) * u1[0], silu_f(g1[1]) * u1[1]); w.w = cvt_pk_bf16(silu_f(g1[2]) * u1[2], silu_f(g1[3]) * u1[3]);
                *(u32x4*)(O + (size_t)row * 2816 + col0) = w; }
    }
};
struct EpiF32SS { static constexpr bool PERM = false, AFTER_DRAIN = false;
    float* O; float* ss;
    __device__ __forceinline__ void operator()(const f32x4 (&acc)[2][2][4][2], const Unit& u, int wr, int wc, int fr, int fq) const {
        const int row0 = u.pm * BM + wr * 64 + fr, col0 = u.pn * BM + wc * 32 + 4 * fq;
#pragma unroll
        for (int ai = 0; ai < 2; ++ai)
#pragma unroll
            for (int m = 0; m < 4; ++m) { const int row = row0 + ai * HALF + m * 16; float q = 0.f;
#pragma unroll
                for (int bj = 0; bj < 2; ++bj)
#pragma unroll
                    for (int n = 0; n < 2; ++n) { const f32x4 v = acc[ai][bj][m][n]; *(f32x4*)(O + (size_t)row * 1024 + col0 + bj * HALF + n * 16) = v;
                        q += (v[0] * v[0] + v[1] * v[1]) + (v[2] * v[2] + v[3] * v[3]); }
                q += __shfl_xor(q, 16); q += __shfl_xor(q, 32);
                if (fq == 0) ss[(size_t)row * 16 + u.pn * 4 + wc] = q; }
    }
};
struct SplitOrder {
    int S, nun, G, c;
    __host__ __device__ void init(int S_, int G_, int c_) { S = S_; nun = 16 * S_; G = G_; c = c_; }
    __host__ __device__ bool next(int i, Unit& u) const { const int L = i * G + c; if (L >= nun) return false; const int tile = L / S; u.ks = L - tile * S; u.pm = 64 + (tile >> 2); u.pn = tile & 3; return true; }
    __device__ __forceinline__ void a_ready(const Unit&) const {}
    __device__ __forceinline__ void done(const Unit&) const {}
};
struct EpiF32 { static constexpr bool PERM = false, AFTER_DRAIN = false;
    float* O;
    __device__ __forceinline__ void operator()(const f32x4 (&acc)[2][2][4][2], const Unit& u, int wr, int wc, int fr, int fq) const {
        const int row0 = u.pm * BM + wr * 64 + fr, col0 = u.pn * BM + wc * 32 + 4 * fq;
#pragma unroll
        for (int ai = 0; ai < 2; ++ai)
#pragma unroll
            for (int m = 0; m < 4; ++m) { const int row = row0 + ai * HALF + m * 16;
#pragma unroll
                for (int bj = 0; bj < 2; ++bj)
#pragma unroll
                    for (int n = 0; n < 2; ++n) *(f32x4*)(O + (size_t)row * 1024 + col0 + bj * HALF + n * 16) = acc[ai][bj][m][n]; }
    }
};
struct EpiB16 { static constexpr bool PERM = true, AFTER_DRAIN = false;
    bf16_t* O;
    __device__ __forceinline__ void operator()(const f32x4 (&acc)[2][2][4][2], const Unit& u, int wr, int wc, int fr, int fq) const {
        const int row0 = u.pm * BM + wr * 64 + fr, col0 = u.pn * BM + wc * 32 + 8 * fq;
#pragma unroll
        for (int ai = 0; ai < 2; ++ai)
#pragma unroll
            for (int m = 0; m < 4; ++m) { const int row = row0 + ai * HALF + m * 16;
#pragma unroll
                for (int bj = 0; bj < 2; ++bj) { const f32x4 v0 = acc[ai][bj][m][0], v1 = acc[ai][bj][m][1]; u32x4 w;
                    w.x = cvt_pk_bf16(v0[0], v0[1]); w.y = cvt_pk_bf16(v0[2], v0[3]); w.z = cvt_pk_bf16(v1[0], v1[1]); w.w = cvt_pk_bf16(v1[2], v1[3]);
                    *(u32x4*)(O + (size_t)row * 1024 + col0 + bj * HALF) = w; } }
    }
};
struct EpiPart { static constexpr bool PERM = false, AFTER_DRAIN = false;
    float* O;
    __device__ __forceinline__ void operator()(const f32x4 (&acc)[2][2][4][2], const Unit& u, int wr, int wc, int fr, int fq) const {
        const int row0 = (u.pm - 64) * BM + wr * 64 + fr, col0 = u.pn * BM + wc * 32 + 4 * fq;
        float* Ob = O + (size_t)u.ks * 1024 * 1024;
#pragma unroll
        for (int ai = 0; ai < 2; ++ai)
#pragma unroll
            for (int m = 0; m < 4; ++m) { const int row = row0 + ai * HALF + m * 16;
#pragma unroll
                for (int bj = 0; bj < 2; ++bj)
#pragma unroll
                    for (int n = 0; n < 2; ++n) *(f32x4*)(Ob + (size_t)row * 1024 + col0 + bj * HALF + n * 16) = acc[ai][bj][m][n]; }
    }
};
struct EpiScale { static constexpr bool PERM = true, AFTER_DRAIN = false;
    bf16_t* O; int ldc; const float* rs;
    __device__ __forceinline__ void operator()(const f32x4 (&acc)[2][2][4][2], const Unit& u, int wr, int wc, int fr, int fq) const {
        const int row0 = u.pm * BM + wr * 64 + fr, col0 = u.pn * BM + wc * 32 + 8 * fq;
#pragma unroll
        for (int ai = 0; ai < 2; ++ai)
#pragma unroll
            for (int m = 0; m < 4; ++m) { const int row = row0 + ai * HALF + m * 16; const float s = rs[row];
#pragma unroll
                for (int bj = 0; bj < 2; ++bj) { const f32x4 v0 = acc[ai][bj][m][0] * s, v1 = acc[ai][bj][m][1] * s; u32x4 w;
                    w.x = cvt_pk_bf16(v0[0], v0[1]); w.y = cvt_pk_bf16(v0[2], v0[3]); w.z = cvt_pk_bf16(v1[0], v1[1]); w.w = cvt_pk_bf16(v1[2], v1[3]);
                    *(u32x4*)(O + (size_t)row * ldc + col0 + bj * HALF) = w; } }
    }
};
struct EpiRet { static constexpr bool PERM = true, AFTER_DRAIN = false;
    bf16_t* O; const float* rs; const float* cosT; const float* sinT;
    __device__ __forceinline__ void operator()(const f32x4 (&acc)[2][2][4][2], const Unit& u, int wr, int wc, int fr, int fq) const {
        const int row0 = u.pm * BM + wr * 64 + fr, col0 = u.pn * BM + wc * 32 + 8 * fq;
        const bool rot = u.pn < 8; const int hh = u.pn & 3; const bool isk = u.pn >= 4;
        const float l2g = __log2f(1.0f - exp2f(-5.0f - (float)hh));
#pragma unroll
        for (int ai = 0; ai < 2; ++ai)
#pragma unroll
            for (int m = 0; m < 4; ++m) { const int row = row0 + ai * HALF + m * 16; float s = rs[row];
                if (!rot) {
#pragma unroll
                    for (int bj = 0; bj < 2; ++bj) { const f32x4 v0 = acc[ai][bj][m][0] * s, v1 = acc[ai][bj][m][1] * s; u32x4 w;
                        w.x = cvt_pk_bf16(v0[0], v0[1]); w.y = cvt_pk_bf16(v0[2], v0[3]); w.z = cvt_pk_bf16(v1[0], v1[1]); w.w = cvt_pk_bf16(v1[2], v1[3]);
                        *(u32x4*)(O + (size_t)row * 6144 + col0 + bj * HALF) = w; }
                } else {
                    int pi; float sc;
                    if (row < MPROMPT) { const int pos = row & 2047, tau = pos & 255; pi = pos;
                        sc = isk ? exp2f((float)(128 - tau) * l2g) * 0.0625f : exp2f((float)(tau - 128) * l2g); }
                    else { pi = 2048 + (row & 7); sc = isk ? 0.0625f : 1.0f; }
                    s *= sc;
                    const int fi = wc * 32 + 8 * fq;
                    const f32x4 c0 = *(const f32x4*)(cosT + pi * 128 + fi), c1 = *(const f32x4*)(cosT + pi * 128 + fi + 4);
                    const f32x4 s0 = *(const f32x4*)(sinT + pi * 128 + fi), s1 = *(const f32x4*)(sinT + pi * 128 + fi + 4);
                    const f32x4 a0 = acc[ai][0][m][0] * s, a1 = acc[ai][0][m][1] * s, b0 = acc[ai][1][m][0] * s, b1 = acc[ai][1][m][1] * s;
                    const f32x4 p0 = a0 * c0 - b0 * s0, p1 = a1 * c1 - b1 * s1, q0 = a0 * s0 + b0 * c0, q1 = a1 * s1 + b1 * c1;
                    u32x4 w;
                    w.x = cvt_pk_bf16(p0[0], p0[1]); w.y = cvt_pk_bf16(p0[2], p0[3]); w.z = cvt_pk_bf16(p1[0], p1[1]); w.w = cvt_pk_bf16(p1[2], p1[3]);
                    *(u32x4*)(O + (size_t)row * 6144 + col0) = w;
                    w.x = cvt_pk_bf16(q0[0], q0[1]); w.y = cvt_pk_bf16(q0[2], q0[3]); w.z = cvt_pk_bf16(q1[0], q1[1]); w.w = cvt_pk_bf16(q1[2], q1[3]);
                    *(u32x4*)(O + (size_t)row * 6144 + col0 + HALF) = w;
                } }
    }
};

template <class Epi, class Sched, bool ALIGN_EPI = false, bool SP2 = false>
__device__ __forceinline__ void gemm_phase(PG8_LAS unsigned char* lds, const Gemm g, const Sched& S, const Epi& E) {
    const int tid = otid(), wid = __builtin_amdgcn_readfirstlane(tid >> 6), lane = tid & 63, wr = wid >> 2, wc = wid & 3, fr = lane & 15, fq = lane >> 4;
    const int K = g.K, nt = K / BK;
    unsigned voffA[2], voffB[2];
#pragma unroll
    for (int i = 0; i < 2; ++i) { int R, C; stage_rc(tid * 16 + i * 8192, R, C); const int Rb = Epi::PERM ? ((R & ~31) + perm32(R & 31)) : R;
        voffA[i] = (unsigned)(R * g.ld + C) * 2u; voffB[i] = (unsigned)(Rb * g.ld + C) * 2u; }
    const size_t kstep = (size_t)(BK * 2);
    const size_t hstep = (size_t)HALF * g.ld * 2;
    const size_t tstep = 2 * hstep;
    const unsigned ldsw = (unsigned)wid * 1024u;
    const int aoff = lds_byte(wr * 64 + fr, fq * 8), boff = lds_byte(wc * 32 + fr, fq * 8);
#define PG8_SA(b, h) (((b) * 2 + (h)) * HTB)
#define PG8_SB(b, h) ((4 + (b) * 2 + (h)) * HTB)
#define PG8_STAGE(bufoff, gbase, voff) do { _Pragma("unroll") for (int _i = 0; _i < 2; ++_i) \
        __builtin_amdgcn_global_load_lds((const unsigned*)((const char*)(gbase) + (voff)[_i]), (PG8_LAS unsigned*)(lds + (bufoff) + ldsw + _i * 8192), 16, 0, 0); } while (0)
#define PG8_LDA(dst, b, h) do { _Pragma("unroll") for (int m = 0; m < 4; ++m) _Pragma("unroll") for (int k = 0; k < 2; ++k) dst[m][k] = *(const PG8_LAS bf16x8*)(lds + PG8_SA(b, h) + aoff + m * 2048 + k * 1024); } while (0)
#define PG8_LDB(dst, b, h) do { _Pragma("unroll") for (int n = 0; n < 2; ++n) _Pragma("unroll") for (int k = 0; k < 2; ++k) dst[n][k] = *(const PG8_LAS bf16x8*)(lds + PG8_SB(b, h) + boff + n * 2048 + k * 1024); } while (0)
#define PG8_MMA(ai, bj, At, Bt) do { __builtin_amdgcn_s_setprio(1); _Pragma("unroll") for (int m = 0; m < 4; ++m) _Pragma("unroll") for (int n = 0; n < 2; ++n) _Pragma("unroll") for (int k = 0; k < 2; ++k) \
        acc[ai][bj][m][n] = __builtin_amdgcn_mfma_f32_16x16x32_bf16(Bt[n][k], At[m][k], acc[ai][bj][m][n], 0, 0, 0); __builtin_amdgcn_s_setprio(0); } while (0)
#define PG8_WAIT_V(n) asm volatile("s_waitcnt vmcnt(" #n ")" ::: "memory")
#define PG8_WAIT_L(n) asm volatile("s_waitcnt lgkmcnt(" #n ")" ::: "memory")
#define PG8_BAR __builtin_amdgcn_s_barrier()
#define PG8_SCHED __builtin_amdgcn_sched_barrier(0)
    Unit cur, nxt; int ui = 0;
    if (!S.next(0, cur)) return;
    f32x4 acc[2][2][4][2];
#pragma unroll
    for (int a = 0; a < 2; ++a)
#pragma unroll
        for (int b = 0; b < 2; ++b)
#pragma unroll
            for (int m = 0; m < 4; ++m)
#pragma unroll
                for (int n = 0; n < 2; ++n) acc[a][b][m][n] = (f32x4){0.f, 0.f, 0.f, 0.f};
    bf16x8 At[4][2], B0[2][2], B1[2][2];
    const char* cA = (const char*)g.A + (size_t)cur.pm * tstep + (size_t)cur.ks * K * 2; const char* cB = (const char*)g.Bt + (size_t)cur.pn * tstep + (size_t)cur.ks * K * 2;
    S.a_ready(cur);
    if constexpr (SP2) {
        PG8_STAGE(PG8_SB(0, 0), cB, voffB); PG8_STAGE(PG8_SB(0, 1), cB + hstep, voffB); PG8_STAGE(PG8_SA(0, 0), cA, voffA); PG8_STAGE(PG8_SA(0, 1), cA + hstep, voffA);
        if (wr == 1) PG8_BAR;
        PG8_WAIT_V(2); PG8_BAR;
        PG8_STAGE(PG8_SB(1, 0), cB + kstep, voffB); PG8_STAGE(PG8_SA(1, 0), cA + kstep, voffA); PG8_STAGE(PG8_SB(1, 1), cB + hstep + kstep, voffB);
        PG8_WAIT_V(6); PG8_BAR;
    } else {
        PG8_STAGE(PG8_SB(0, 0), cB, voffB); PG8_STAGE(PG8_SA(0, 0), cA, voffA); PG8_STAGE(PG8_SB(0, 1), cB + hstep, voffB); PG8_STAGE(PG8_SA(0, 1), cA + hstep, voffA);
        if (wr == 1) PG8_BAR;
        PG8_WAIT_V(4); PG8_BAR;
        PG8_STAGE(PG8_SB(1, 0), cB + kstep, voffB); PG8_STAGE(PG8_SA(1, 0), cA + kstep, voffA); PG8_STAGE(PG8_SB(1, 1), cB + hstep + kstep, voffB);
        PG8_WAIT_V(6); PG8_BAR;
    }
    for (;;) {
        const bool has_next = S.next(ui + 1, nxt);
        const char* nA = has_next ? (const char*)g.A + (size_t)nxt.pm * tstep + (size_t)nxt.ks * K * 2 : cA; const char* nB = has_next ? (const char*)g.Bt + (size_t)nxt.pn * tstep + (size_t)nxt.ks * K * 2 : cB;
        for (int t = 0; t < nt; t += 2) {
            const bool last = (t == nt - 2);
            const char* a1 = cA + (size_t)(t + 1) * kstep;
            const char* a2 = last ? nA : cA + (size_t)(t + 2) * kstep; const char* b2 = last ? nB : cB + (size_t)(t + 2) * kstep;
            const char* a3 = a2 + kstep; const char* b3 = b2 + kstep;
            if (last && has_next) S.a_ready(nxt);
            if constexpr (SP2) {
            PG8_LDB(B0, 0, 0); PG8_LDB(B1, 0, 1); PG8_SCHED; PG8_LDA(At, 0, 0); PG8_STAGE(PG8_SA(1, 1), a1 + hstep, voffA);
            PG8_WAIT_V(8); PG8_WAIT_L(0); PG8_BAR; PG8_MMA(0, 0, At, B0); PG8_MMA(0, 1, At, B1); PG8_BAR; PG8_SCHED;
            PG8_LDA(At, 0, 1); PG8_STAGE(PG8_SB(0, 0), b2, voffB); PG8_STAGE(PG8_SB(0, 1), b2 + hstep, voffB); PG8_STAGE(PG8_SA(0, 0), a2, voffA);
            PG8_WAIT_V(8); PG8_WAIT_L(0); PG8_BAR; PG8_MMA(1, 0, At, B0); PG8_MMA(1, 1, At, B1); PG8_BAR; PG8_SCHED;
            PG8_LDB(B0, 1, 0); PG8_LDB(B1, 1, 1); PG8_SCHED; PG8_LDA(At, 1, 0); PG8_STAGE(PG8_SA(0, 1), a2 + hstep, voffA);
            PG8_WAIT_V(8); PG8_WAIT_L(0); PG8_BAR; PG8_MMA(0, 0, At, B0); PG8_MMA(0, 1, At, B1); PG8_BAR; PG8_SCHED;
            PG8_LDA(At, 1, 1); PG8_STAGE(PG8_SB(1, 0), b3, voffB); PG8_STAGE(PG8_SB(1, 1), b3 + hstep, voffB); PG8_STAGE(PG8_SA(1, 0), a3, voffA);
            PG8_WAIT_V(8); PG8_WAIT_L(0); PG8_BAR; PG8_MMA(1, 0, At, B0); PG8_MMA(1, 1, At, B1); PG8_BAR; PG8_SCHED;
            } else {
            PG8_LDB(B0, 0, 0); PG8_SCHED; PG8_LDA(At, 0, 0); PG8_STAGE(PG8_SA(1, 1), a1 + hstep, voffA);
            PG8_WAIT_L(8); PG8_BAR; PG8_WAIT_L(0); PG8_MMA(0, 0, At, B0); PG8_BAR; PG8_SCHED;
            PG8_LDB(B1, 0, 1); PG8_STAGE(PG8_SB(0, 0), b2, voffB);
            PG8_BAR; PG8_WAIT_L(0); PG8_MMA(0, 1, At, B1); PG8_BAR;
            PG8_LDA(At, 0, 1); PG8_STAGE(PG8_SA(0, 0), a2, voffA);
            PG8_BAR; PG8_WAIT_L(0); PG8_MMA(1, 0, At, B0); PG8_BAR; PG8_SCHED;
            PG8_STAGE(PG8_SB(0, 1), b2 + hstep, voffB);
            PG8_WAIT_V(6); PG8_BAR; PG8_MMA(1, 1, At, B1); PG8_BAR;
            PG8_LDB(B0, 1, 0); PG8_SCHED; PG8_LDA(At, 1, 0); PG8_STAGE(PG8_SA(0, 1), a2 + hstep, voffA);
            PG8_WAIT_L(8); PG8_BAR; PG8_WAIT_L(0); PG8_MMA(0, 0, At, B0); PG8_BAR; PG8_SCHED;
            PG8_LDB(B1, 1, 1); PG8_STAGE(PG8_SB(1, 0), b3, voffB);
            PG8_BAR; PG8_WAIT_L(0); PG8_MMA(0, 1, At, B1); PG8_BAR;
            PG8_LDA(At, 1, 1); PG8_STAGE(PG8_SA(1, 0), a3, voffA);
            PG8_BAR; PG8_WAIT_L(0); PG8_MMA(1, 0, At, B0); PG8_BAR; PG8_SCHED;
            PG8_STAGE(PG8_SB(1, 1), b3 + hstep, voffB);
            PG8_WAIT_V(6); PG8_BAR; PG8_MMA(1, 1, At, B1); PG8_BAR;
            }
        }
        if constexpr (ALIGN_EPI) { if (wr == 0) PG8_BAR; }
        if constexpr (!Epi::AFTER_DRAIN) { E(acc, cur, wr, wc, fr, fq); S.done(cur); }
        if (!has_next) break;
#pragma unroll
        for (int a = 0; a < 2; ++a)
#pragma unroll
            for (int b = 0; b < 2; ++b)
#pragma unroll
                for (int m = 0; m < 4; ++m)
#pragma unroll
                    for (int n = 0; n < 2; ++n) acc[a][b][m][n] = (f32x4){0.f, 0.f, 0.f, 0.f};
        cur = nxt; cA = nA; cB = nB; ++ui;
        if constexpr (ALIGN_EPI) { if (wr == 1) PG8_BAR; }
    }
    PG8_WAIT_V(0);
    if constexpr (!ALIGN_EPI) { if (wr == 0) PG8_BAR; }
    PG8_BAR;
    if constexpr (Epi::AFTER_DRAIN) { E.fused(acc, cur, wr, wc, fr, fq, lds, wid, lane); S.done(cur); }
#undef PG8_SA
#undef PG8_SB
#undef PG8_STAGE
#undef PG8_LDA
#undef PG8_LDB
#undef PG8_MMA
#undef PG8_WAIT_V
#undef PG8_WAIT_L
#undef PG8_BAR
#undef PG8_SCHED
}
}

#define LAS __attribute__((address_space(3)))
typedef unsigned short bf16_t;
typedef short bf16x8 __attribute__((ext_vector_type(8)));
typedef float f32x4 __attribute__((ext_vector_type(4)));
typedef unsigned u32x4 __attribute__((ext_vector_type(4)));
typedef unsigned u32x2 __attribute__((ext_vector_type(2)));
typedef LAS unsigned char* ldsp;

constexpr int D = 1024, FF = 2816, MP = 16384, MS = 1024, M = MP + MS, NUP = 2 * FF, NE = 3840, NO = 6144;
constexpr float EPS = 1e-6f;
constexpr int E_QA = 0, E_KA = 256, E_VA = 512, E_RA = 1024, E_QB = 1536, E_FB = 2048, E_IB = 2560, E_GB = 3072, E_LR = 3584;
constexpr int O_Q = 0, O_K = 1024, O_V = 2048, O_G = 4096;
constexpr int NTHREADS = 512;
constexpr int LDS_BYTES = 155648;
#ifndef TREP_UP
#define TREP_UP 1
#endif
#ifndef TREP_IN
#define TREP_IN 1
#endif
#ifndef TREP_DN
#define TREP_DN 1
#endif
#ifndef REP_P0
#define REP_P0 1
#endif
#ifndef REP_ME
#define REP_ME 1
#endif
#ifndef REP_MO
#define REP_MO 1
#endif
#ifndef REP_OA
#define REP_OA 1
#endif
#ifndef REP_OB
#define REP_OB 1
#endif
#ifndef REP_OS
#define REP_OS 1
#endif
#ifndef REP_OC
#define REP_OC 1
#endif
#ifndef REP_UP
#define REP_UP 1
#endif
#ifndef REP_G
#define REP_G 1
#endif
#ifndef REP_M
#define REP_M 1
#endif
#ifndef EXTRA_SYNCS
#define EXTRA_SYNCS 0
#endif
#ifndef STOPAT
#define STOPAT 1000
#endif
#ifndef PHMASK
#define PHMASK 0xFFFF
#define DBGSKIP 0
#define NANFIX2 1
#endif

constexpr size_t al256(size_t x) { return (x + 255) & ~(size_t)255; }
constexpr size_t SZ_WUP = (size_t)NUP * D * 2, SZ_WDN = (size_t)D * FF * 2;
constexpr size_t WS_WUP = 0;
constexpr size_t WS_WDN = WS_WUP + 4 * SZ_WUP;
constexpr size_t WS_WINE = WS_WDN + 4 * SZ_WDN;
constexpr size_t WS_WOUTE = WS_WINE + (size_t)NE * D * 2;
constexpr size_t WS_WINO = WS_WOUTE + (size_t)D * D * 2;
constexpr size_t WS_WOUTO = WS_WINO + (size_t)NO * D * 2;
constexpr size_t WS_XB = WS_WOUTO + (size_t)D * 2048 * 2;
constexpr size_t WS_RS = WS_XB + (size_t)M * D * 2;
constexpr size_t WS_SS = WS_RS + al256((size_t)M * 4);
constexpr size_t WS_ACT = WS_SS + al256((size_t)M * 16 * 4);
constexpr size_t WS_F = WS_ACT + (size_t)M * FF * 2;
constexpr size_t WS_P = WS_F + (size_t)M * D * 4;
constexpr size_t WS_Y = WS_P + (size_t)M * NO * 2;
constexpr size_t WS_QT = WS_Y + (size_t)M * 2048 * 2;
constexpr size_t WS_QH = WS_QT + (size_t)MP * 768 * 2;
constexpr size_t WS_KT = WS_QH + (size_t)MP * 768 * 2;
constexpr size_t WS_HL = WS_KT + (size_t)MP * 768 * 2;
constexpr size_t HL_HGRN = (size_t)1024 * 128 * 64 * 4;
constexpr size_t WS_DEC = WS_HL + (size_t)134217728;
constexpr size_t DEC_HGRN = (size_t)1024 * 64 * 4;
constexpr size_t WS_ST = WS_DEC + (size_t)1048576;
constexpr size_t ST_HGRN = (size_t)1024 * 128 * 64 * 2;
constexpr size_t WS_COS = WS_ST + (size_t)67108864;
constexpr size_t WS_SIN = WS_COS + al256((size_t)2056 * 128 * 4);
constexpr size_t WS_BAR = WS_SIN + al256((size_t)2056 * 128 * 4);
constexpr size_t WS_PART = WS_BAR + 16384;
constexpr size_t WS_END = WS_PART + (size_t)11 * 1024 * 1024 * 4;

constexpr size_t OUT_GLA_P = 17825792, OUT_HGRN_P = 18087936, OUT_RET_P = 18612224, OUT_GLA_S = 22806528, OUT_HGRN_S = 27000832, OUT_RET_S = 35389440;

struct Params { const float* in[19]; float* out; unsigned char* ws; };

__device__ __forceinline__ unsigned f2bf(float f) { unsigned u = __builtin_bit_cast(unsigned, f); return (u + 0x7fffu + ((u >> 16) & 1u)) >> 16; }
__device__ __forceinline__ float bf2f(unsigned u) { return __builtin_bit_cast(float, u << 16); }
__device__ __forceinline__ unsigned pk2(float lo, float hi) { return pg8::cvt_pk_bf16(lo, hi); }
__device__ __forceinline__ float siluf(float x) { return x * __builtin_amdgcn_rcpf(1.0f + __expf(-x)); }
__device__ __forceinline__ float wave_sum(float v) {
#pragma unroll
    for (int o = 1; o < 64; o <<= 1) v += __shfl_xor(v, o);
    return v;
}
__device__ __forceinline__ f32x4 mma16(bf16x8 a, bf16x8 b, f32x4 c) { return __builtin_amdgcn_mfma_f32_16x16x32_bf16(a, b, c, 0, 0, 0); }
__device__ __forceinline__ bf16x8 ldfrag(ldsp base, int elem) { return *(const LAS bf16x8*)(base + (size_t)elem * 2); }
__device__ __forceinline__ float logsig(float x) { return fminf(x, 0.f) - __logf(1.0f + __expf(-fabsf(x))); }

template <int F> __device__ __forceinline__ void stage_rows(ldsp dst, int dp, const bf16_t* src, size_t sp, int tid) {
    constexpr int G8 = F / 8;
#pragma unroll
    for (int it = 0; it < (64 * G8) / NTHREADS; ++it) { const int idx = tid + it * NTHREADS; const int s = idx / G8, g = idx % G8;
        const u32x4 w = *(const u32x4*)(src + (size_t)s * sp + g * 8);
        *(LAS u32x4*)(dst + (size_t)(s * dp + g * 8) * 2) = w; }
}
template <int F> __device__ __forceinline__ void stage_T(ldsp dst, int dp_unused, const bf16_t* src, size_t sp, int wave, int lane) {
    const bf16_t* gb = src + (size_t)(32 * (wave & 1) + (lane & 31)) * sp + (2 * (wave >> 1) + (lane >> 5)) * 8;
    ldsp base = dst + (size_t)((2 * (wave >> 1) + (lane >> 5)) * 8 * 72 + 32 * (wave & 1) + (lane & 31)) * 2;
    constexpr int UF = (F / 64 > 2) ? 2 : F / 64;
#pragma unroll UF
    for (int it = 0; it < F / 64; ++it) { const u32x4 w = *(const u32x4*)(gb + 64 * it);
#pragma unroll
        for (int i = 0; i < 4; ++i) {
            *(LAS bf16_t*)(base + (64 * it + 2 * i) * 144) = (bf16_t)(w[i] & 0xffffu);
            *(LAS bf16_t*)(base + (64 * it + 2 * i + 1) * 144) = (bf16_t)(w[i] >> 16); } }
}

template <int F> __device__ __forceinline__ void ld_rows(u32x4 (&r)[(64 * (F / 8)) / NTHREADS], const bf16_t* src, size_t sp, int tid) {
    constexpr int G8 = F / 8;
#pragma unroll
    for (int it = 0; it < (64 * G8) / NTHREADS; ++it) { const int idx = tid + it * NTHREADS; const int s = idx / G8, g = idx % G8; r[it] = *(const u32x4*)(src + (size_t)s * sp + g * 8); }
}
template <int F> __device__ __forceinline__ void st_rows(ldsp dst, int dp, const u32x4 (&r)[(64 * (F / 8)) / NTHREADS], int tid) {
    constexpr int G8 = F / 8;
#pragma unroll
    for (int it = 0; it < (64 * G8) / NTHREADS; ++it) { const int idx = tid + it * NTHREADS; const int s = idx / G8, g = idx % G8; *(LAS u32x4*)(dst + (size_t)(s * dp + g * 8) * 2) = r[it]; }
}
template <int F> __device__ __forceinline__ void ld_T(u32x4 (&r)[F / 64], const bf16_t* src, size_t sp, int wave, int lane) {
    const bf16_t* base = src + (size_t)(32 * (wave & 1) + (lane & 31)) * sp + (2 * (wave >> 1) + (lane >> 5)) * 8;
#pragma unroll
    for (int it = 0; it < F / 64; ++it) r[it] = *(const u32x4*)(base + 64 * it);
}
template <int F> __device__ __forceinline__ void st_T(ldsp dst, int dp_unused, const u32x4 (&r)[F / 64], int wave, int lane) {
    ldsp base = dst + (size_t)((2 * (wave >> 1) + (lane >> 5)) * 8 * 72 + 32 * (wave & 1) + (lane & 31)) * 2;
#pragma unroll
    for (int it = 0; it < F / 64; ++it) { const u32x4 w = r[it];
#pragma unroll
        for (int i = 0; i < 4; ++i) {
            *(LAS bf16_t*)(base + (64 * it + 2 * i) * 144) = (bf16_t)(w[i] & 0xffffu);
            *(LAS bf16_t*)(base + (64 * it + 2 * i + 1) * 144) = (bf16_t)(w[i] >> 16); } }
}
__device__ __forceinline__ void row_pass(const Params& p, int mode, float coef, const float* nw, int nsplit) {
    const int tid = otid(), lane = tid & 63, wave = tid >> 6;
    const int gw = blockIdx.x * 8 + wave, NGW = gridDim.x * 8;
    float* RS = (float*)(p.ws + WS_RS); const bf16_t* Fb = (const bf16_t*)(p.ws + WS_F); bf16_t* XB = (bf16_t*)(p.ws + WS_XB);
    const bool xcd_map = gridDim.x == 256; const int wx = (blockIdx.x >> 3) * 8 + wave;
    for (int it = 0; it < (xcd_map ? 9 : (M + NGW - 1) / NGW); ++it) {
        int r;
        if (xcd_map) { if (it < 8) r = 2048 * (blockIdx.x & 7) + wx + 256 * it; else { r = MP + gw; if (gw >= MS) break; } }
        else { r = gw + it * NGW; if (r >= M) break; }
        u32x2* B2 = (u32x2*)(XB + (size_t)r * D);
        f32x4 v[4];
        if (mode == 0) { const f32x4* s4 = (r < MP) ? (const f32x4*)(p.in[0] + (size_t)r * D) : (const f32x4*)(p.in[1] + (size_t)(r - MP) * D);
#pragma unroll
            for (int j = 0; j < 4; ++j) v[j] = __builtin_nontemporal_load(s4 + 64 * j + lane);
        } else { f32x4 fv[4]; u32x2 xw[4];
#pragma unroll
            for (int j = 0; j < 4; ++j) xw[j] = B2[64 * j + lane];
            if (r < MP) { const u32x2* F2 = (const u32x2*)(Fb + (size_t)r * D);
#pragma unroll
                for (int j = 0; j < 4; ++j) { const u32x2 w = __builtin_nontemporal_load(F2 + 64 * j + lane); fv[j] = (f32x4){bf2f(w.x & 0xffffu), bf2f(w.x >> 16), bf2f(w.y & 0xffffu), bf2f(w.y >> 16)}; }
            } else { const f32x4* P4 = (const f32x4*)(p.ws + WS_PART) + (size_t)(r - MP) * 256;
#pragma unroll
                for (int j = 0; j < 4; ++j) fv[j] = (f32x4){0.f, 0.f, 0.f, 0.f};
                for (int ks = 0; ks < nsplit; ++ks) {
#pragma unroll
                    for (int j = 0; j < 4; ++j) fv[j] += __builtin_nontemporal_load(P4 + (size_t)ks * 262144 + 64 * j + lane); } }
            float q = 0.f;
#pragma unroll
            for (int j = 0; j < 4; ++j) q += (fv[j][0] * fv[j][0] + fv[j][1] * fv[j][1]) + (fv[j][2] * fv[j][2] + fv[j][3] * fv[j][3]);
            q = wave_sum(q);
            const float rstd = rsqrtf(q * (1.0f / D) + EPS) * coef; const f32x4* W4 = (const f32x4*)nw;
#pragma unroll
            for (int j = 0; j < 4; ++j) { const f32x4 xv = (f32x4){bf2f(xw[j].x & 0xffffu), bf2f(xw[j].x >> 16), bf2f(xw[j].y & 0xffffu), bf2f(xw[j].y >> 16)};
                v[j] = xv + fv[j] * W4[64 * j + lane] * rstd; }
        }
        if (mode == 2) { f32x4* X4 = (f32x4*)(p.out + (size_t)r * D);
#pragma unroll
            for (int j = 0; j < 4; ++j) X4[64 * j + lane] = v[j];
        } else {
            float s = 0.f;
#pragma unroll
            for (int j = 0; j < 4; ++j) s += (v[j][0] * v[j][0] + v[j][1] * v[j][1]) + (v[j][2] * v[j][2] + v[j][3] * v[j][3]);
            s = wave_sum(s);
#pragma unroll
            for (int j = 0; j < 4; ++j) { u32x2 w; w.x = pk2(v[j][0], v[j][1]); w.y = pk2(v[j][2], v[j][3]); B2[64 * j + lane] = w; }
            if (lane == 0) RS[r] = rsqrtf(s * (1.0f / D) + EPS);
        }
    }
}

__device__ __forceinline__ int dst_row(int n, int mode) {
    if (mode == 1) return ((n >> 7) << 8) + (n & 127);
    if (mode == 2) return ((n >> 7) << 8) + 128 + (n & 127);
    if (mode == 3) return n < 1536 ? n : (n < 1552 ? n + 2048 : n - 16);
    return n;
}
__device__ __forceinline__ void transpose_item(const float* W, int K, int N, bf16_t* WT, int mode, const float* ksc, LAS float* scr, int item, int lane) {
    const int nblk = (N + 31) / 32, kb = item / nblk, nb = item % nblk, k0 = 64 * kb, n0 = 32 * nb;
    const int nn = n0 + (lane & 31);
    float tv[32];
#pragma unroll
    for (int i = 0; i < 32; ++i) { const int kk = 2 * i + (lane >> 5); tv[i] = (nn < N) ? __builtin_nontemporal_load(W + (size_t)(k0 + kk) * N + nn) : 0.f; }
#pragma unroll
    for (int i = 0; i < 32; ++i) { const int kk = 2 * i + (lane >> 5); float v = tv[i]; if (ksc) v *= ksc[k0 + kk]; scr[kk * 33 + (lane & 31)] = v; }
    asm volatile("s_waitcnt lgkmcnt(0)" ::: "memory");
    const int c = lane & 7;
#pragma unroll
    for (int j = 0; j < 4; ++j) { const int nl = (lane >> 3) + 8 * j; const LAS float* s = scr + (8 * c) * 33 + nl;
        u32x4 o; o.x = pk2(s[0 * 33], s[1 * 33]); o.y = pk2(s[2 * 33], s[3 * 33]); o.z = pk2(s[4 * 33], s[5 * 33]); o.w = pk2(s[6 * 33], s[7 * 33]);
        if (n0 + nl < N) *(u32x4*)(WT + (size_t)dst_row(n0 + nl, mode) * K + k0 + 8 * c) = o; }
    asm volatile("s_waitcnt lgkmcnt(0)" ::: "memory");
}
__device__ __forceinline__ void prologue(const Params& p, ldsp lds) {
    const int tid = otid(), lane = tid & 63, wave = tid >> 6;
    LAS float* scr = (LAS float*)(lds + wave * 16384);
    const int gw = blockIdx.x * 8 + wave, NGW = gridDim.x * 8;
    const float* nw = p.in[5];
    constexpr int I_UP = 16 * 88, I_DN = 44 * 32, I_EI = 16 * 113, I_EO = 16 * 32, I_OI = 16 * 192, I_OO = 32 * 32;
    constexpr int NITEMS = 8 * I_UP + 4 * I_DN + I_EI + I_EO + I_OI + I_OO;
    for (int it = gw; it < NITEMS; it += NGW) {
        int r = it;
        if (r < 8 * I_UP) { const int f = r / (2 * I_UP), rr = r % (2 * I_UP), isup = rr >= I_UP, ii = rr % I_UP; const int l = f >> 1, j = f & 1;
            transpose_item((isup ? p.in[7] : p.in[6]) + (size_t)f * D * FF, D, FF, (bf16_t*)(p.ws + WS_WUP + f * SZ_WUP), isup ? 2 : 1, nw + (l * 6 + (j ? 4 : 0)) * D, scr, ii, lane); continue; }
        r -= 8 * I_UP;
        if (r < 4 * I_DN) { const int f = r / I_DN, ii = r % I_DN;
            transpose_item(p.in[8] + (size_t)f * FF * D, FF, D, (bf16_t*)(p.ws + WS_WDN + f * SZ_WDN), 0, nullptr, scr, ii, lane); continue; }
        r -= 4 * I_DN;
        if (r < I_EI) { transpose_item(p.in[9], D, 3600, (bf16_t*)(p.ws + WS_WINE), 3, nw + 2 * D, scr, r, lane); continue; }
        r -= I_EI;
        if (r < I_EO) { transpose_item(p.in[15], D, D, (bf16_t*)(p.ws + WS_WOUTE), 0, nullptr, scr, r, lane); continue; }
        r -= I_EO;
        if (r < I_OI) { transpose_item(p.in[16], D, NO, (bf16_t*)(p.ws + WS_WINO), 0, nw + 8 * D, scr, r, lane); continue; }
        r -= I_OI;
        transpose_item(p.in[18], 2048, D, (bf16_t*)(p.ws + WS_WOUTO), 0, nullptr, scr, r, lane);
    }
    const int gtid = blockIdx.x * NTHREADS + tid, GT = gridDim.x * NTHREADS;
    { u32x4* z = (u32x4*)(p.ws + WS_WINE + (size_t)3600 * D * 2); for (int i = gtid; i < 240 * D / 8; i += GT) z[i] = (u32x4){0u, 0u, 0u, 0u}; }
    { float* cosT = (float*)(p.ws + WS_COS); float* sinT = (float*)(p.ws + WS_SIN);
      for (int i = gtid; i < 2056 * 128; i += GT) { const int pi = i >> 7, fi = i & 127; const int pos = pi < 2048 ? pi : 16384 + pi - 2048;
          const float inv = powf(10000.0f, -(float)fi / 128.0f); const float ang = (float)pos * inv;
          const double rev = (double)ang * 0.15915494309189533577; const float fr = (float)(rev - rint(rev));
          cosT[i] = __builtin_amdgcn_cosf(fr); sinT[i] = __builtin_amdgcn_sinf(fr); } }
    row_pass(p, 0, 0.f, nullptr, 0);
}

#define BSYNC() do { asm volatile("s_waitcnt vmcnt(0) lgkmcnt(0)" ::: "memory"); __syncthreads(); } while (0)
template <int TY> __device__ __forceinline__ void ma_even_item(const Params& p, ldsp lds, int item) {
    constexpr int DK = TY ? 128 : 64, NSEG = NTHREADS / DK, SEGL = 64 / NSEG;
    const int tid = otid(), lane = tid & 63, wave = __builtin_amdgcn_readfirstlane(tid >> 6), l15 = lane & 15, q4 = lane >> 4;
    const int bh = item >> 5, c = item & 31, b = bh >> 2, h = bh & 3, row0 = b * 2048 + c * 64;
    const int d = tid % DK, sg = tid / DK;
    LAS float* Bl = (LAS float*)lds; LAS float* SEG = (LAS float*)(lds + 32768); LAS float* LRs = (LAS float*)(lds + 36864);
    ldsp KHT = lds + 40960; ldsp VT = lds + 59392;
    const bf16_t* Pb = (const bf16_t*)(p.ws + WS_P) + (size_t)row0 * NE;
    if (TY == 0) { for (int idx = tid; idx < 1024; idx += NTHREADS) LRs[idx] = bf2f(Pb[(size_t)(idx >> 4) * NE + E_LR + (idx & 15)]); }
    stage_T<128>(VT, 72, Pb + (TY ? E_IB : E_VA) + h * 128, NE, wave, lane);
    float w2[16]; float bias = 0.f, lbv = 0.f;
    if (TY == 0) {
#pragma unroll
        for (int r = 0; r < 16; ++r) w2[r] = p.in[10][r * 256 + h * 64 + d];
        bias = p.in[11][h * 64 + d];
    } else { const float t0 = p.in[13][h * 128 + d], t1 = p.in[13][512 + h * 128 + d], t2 = p.in[13][1024 + h * 128 + d];
        const float mx = fmaxf(t0, fmaxf(t1, t2)); const float e0 = __expf(t0 - mx), e1 = __expf(t1 - mx), e2 = __expf(t2 - mx); lbv = e0 / (e0 + e1 + e2); }
    BSYNC();
    float run = 0.f;
#pragma unroll
    for (int i = 0; i < SEGL; ++i) { const int s = sg * SEGL + i; float g;
        if (TY == 0) { float x = bias;
#pragma unroll
            for (int r = 0; r < 16; ++r) x += LRs[s * 16 + r] * w2[r];
            g = logsig(x) * 0.0625f;
        } else { const float x = bf2f(Pb[(size_t)s * NE + E_FB + h * 128 + d]); const float sig = __builtin_amdgcn_rcpf(1.0f + __expf(-x)); g = __logf(lbv + (1.0f - lbv) * sig); }
        run += g; Bl[s * DK + d] = run; }
    SEG[sg * 128 + d] = run;
    BSYNC();
    float off = 0.f, tot = 0.f;
#pragma unroll
    for (int s2 = 0; s2 < NSEG; ++s2) { const float v = SEG[s2 * 128 + d]; if (s2 < sg) off += v; tot += v; }
#pragma unroll
    for (int i = 0; i < SEGL; ++i) Bl[(sg * SEGL + i) * DK + d] += off;
    BSYNC();
    const float bmid = Bl[31 * DK + d], blast = tot;
    bf16_t* QT = (bf16_t*)(p.ws + WS_QT); bf16_t* QH = (bf16_t*)(p.ws + WS_QH); bf16_t* KT = (bf16_t*)(p.ws + WS_KT);
    const int col = TY ? 256 + h * 128 + d : h * 64 + d;
#pragma unroll
    for (int i = 0; i < SEGL; ++i) { const int s = sg * SEGL + i; const float bs = Bl[s * DK + d]; float qv, kv;
        if (TY == 0) { qv = bf2f(Pb[(size_t)s * NE + E_QA + h * 64 + d]) * 0.125f; kv = bf2f(Pb[(size_t)s * NE + E_KA + h * 64 + d]); }
        else { qv = siluf(bf2f(Pb[(size_t)s * NE + E_QB + h * 128 + d])); const float xf = bf2f(Pb[(size_t)s * NE + E_FB + h * 128 + d]); kv = (1.0f - lbv) * __builtin_amdgcn_rcpf(1.0f + __expf(xf)); }
        const size_t g = (size_t)(row0 + s) * 768 + col;
        QT[g] = (bf16_t)f2bf(qv * __expf(fminf(bs - bmid, 80.f))); QH[g] = (bf16_t)f2bf(qv * __expf(bs)); KT[g] = (bf16_t)f2bf(kv * __expf(fminf(bmid - bs, 80.f)));
        *(LAS bf16_t*)(KHT + (size_t)(d * 72 + s) * 2) = (bf16_t)f2bf(kv * __expf(blast - bs)); }
    if (sg == 0) ((float*)(p.ws + WS_DEC + (TY ? DEC_HGRN : 0)))[(size_t)item * DK + d] = __expf(blast);
    BSYNC();
    f32x4 acc[DK / 16];
#pragma unroll
    for (int i = 0; i < DK / 16; ++i) acc[i] = (f32x4){0.f, 0.f, 0.f, 0.f};
#pragma unroll
    for (int ks = 0; ks < 2; ++ks) { const bf16x8 bf = ldfrag(VT, (16 * wave + l15) * 72 + 32 * ks + 8 * q4);
#pragma unroll
        for (int i = 0; i < DK / 16; ++i) acc[i] = mma16(ldfrag(KHT, (16 * i + l15) * 72 + 32 * ks + 8 * q4), bf, acc[i]); }
    bf16_t* HL = (bf16_t*)(p.ws + WS_HL + (TY ? HL_HGRN : 0)) + ((size_t)item * 128 + 16 * wave + l15) * DK;
#pragma unroll
    for (int i = 0; i < DK / 16; ++i) { u32x2 w; w.x = pk2(acc[i][0], acc[i][1]); w.y = pk2(acc[i][2], acc[i][3]); *(u32x2*)(HL + 16 * i + 4 * q4) = w; }
    BSYNC();
}

__device__ __forceinline__ void ma_ret_item(const Params& p, ldsp lds, int item) {
    const int tid = otid(), lane = tid & 63, wave = __builtin_amdgcn_readfirstlane(tid >> 6), l15 = lane & 15, q4 = lane >> 4;
    const int es = item & 3, sc = (item >> 2) & 7, bh = item >> 5, b = bh >> 2, h = bh & 3;
    ldsp KTt = lds; ldsp VTt = lds + 36864;
    const bf16_t* Pb = (const bf16_t*)(p.ws + WS_P);
    f32x4 acc[16];
#pragma unroll
    for (int i = 0; i < 16; ++i) acc[i] = (f32x4){0.f, 0.f, 0.f, 0.f};
    u32x4 kr[4], vr[2];
    { const size_t rowq = (size_t)b * 2048 + (sc * 4) * 64;
      ld_T<256>(kr, Pb + rowq * NO + O_K + h * 256, NO, wave, lane); ld_T<128>(vr, Pb + rowq * NO + O_V + h * 512 + es * 128, NO, wave, lane); }
    for (int j = 0; j < 4; ++j) { const size_t rowj = (size_t)b * 2048 + (sc * 4 + j) * 64;
        st_T<256>(KTt, 72, kr, wave, lane); st_T<128>(VTt, 72, vr, wave, lane);
        __syncthreads();
        if (j < 3) { const size_t rown = rowj + 64; ld_T<256>(kr, Pb + rown * NO + O_K + h * 256, NO, wave, lane); ld_T<128>(vr, Pb + rown * NO + O_V + h * 512 + es * 128, NO, wave, lane); }
#pragma unroll
        for (int ks = 0; ks < 2; ++ks) { const bf16x8 bf = ldfrag(VTt, (16 * wave + l15) * 72 + 32 * ks + 8 * q4);
#pragma unroll
            for (int i = 0; i < 16; ++i) acc[i] = mma16(ldfrag(KTt, (16 * i + l15) * 72 + 32 * ks + 8 * q4), bf, acc[i]); }
        __syncthreads(); }
    bf16_t* HL = (bf16_t*)(p.ws + WS_HL) + (((size_t)bh * 8 + sc) * 512 + es * 128 + 16 * wave + l15) * 256;
#pragma unroll
    for (int i = 0; i < 16; ++i) { u32x2 w; w.x = pk2(acc[i][0], acc[i][1]); w.y = pk2(acc[i][2], acc[i][3]); *(u32x2*)(HL + 16 * i + 4 * q4) = w; }
}

template <int DK, int DV, int NC, bool RET> __device__ __forceinline__ void scan_states(const bf16_t* HL, const float* DEC, bf16_t* ST, float* outp) {
    constexpr int DQ = DK / 4; constexpr int total = 32 * DV * DQ;
    const int gtid = blockIdx.x * NTHREADS + otid(), GT = gridDim.x * NTHREADS;
    for (int idx = gtid; idx < total; idx += GT) {
        const int dq = idx % DQ, e = (idx / DQ) % DV, bh = idx / (DQ * DV);
        f32x4 S = (f32x4){0.f, 0.f, 0.f, 0.f}; float c_st = 1.f, c_dec = 1.f, c_h = 1.f;
        if (RET) { const float l2g = __log2f(1.0f - exp2f(-5.0f - (float)(bh & 3))); c_st = exp2f(129.f * l2g); c_dec = exp2f(256.f * l2g); c_h = exp2f(127.f * l2g); }
#pragma unroll 8
        for (int c = 0; c < NC; ++c) { const size_t base = (((size_t)bh * NC + c) * DV + e) * DK + dq * 4;
            u32x2 w; w.x = pk2(S[0] * c_st, S[1] * c_st); w.y = pk2(S[2] * c_st, S[3] * c_st); *(u32x2*)(ST + base) = w;
            const u32x2 hw = __builtin_nontemporal_load((const u32x2*)(HL + base)); const f32x4 hl = (f32x4){bf2f(hw.x & 0xffffu), bf2f(hw.x >> 16), bf2f(hw.y & 0xffffu), bf2f(hw.y >> 16)};
            f32x4 dec; if (RET) dec = (f32x4){c_dec, c_dec, c_dec, c_dec}; else dec = *(const f32x4*)(DEC + ((size_t)bh * NC + c) * DK + dq * 4);
            S = dec * S + hl * c_h; }
#pragma unroll
        for (int j = 0; j < 4; ++j) outp[((size_t)bh * DK + dq * 4 + j) * DV + e] = S[j];
    }
}

template <int TY> __device__ __forceinline__ void mc_item(const Params& p, ldsp lds, int item) {
    constexpr int DK = TY == 0 ? 64 : (TY == 1 ? 128 : 256), DV = TY == 2 ? 512 : 128, NB = TY == 2 ? 4 : 1, ET = DV / 128, PQ = DK + 8;
    constexpr int szQ = 64 * PQ * 2, o_qh = szQ, o_kt = (TY == 2 ? 1 : 2) * szQ, o_vt = o_kt + szQ, o_pm = o_vt + DV * 144, o_red = o_pm + 64 * 144;
    static_assert(o_red + 2048 <= LDS_BYTES, "mc LDS");
    const int tid = otid(), lane = tid & 63, wave = __builtin_amdgcn_readfirstlane(tid >> 6), l15 = lane & 15, q4 = lane >> 4;
    const int bh = item >> 5, c = item & 31, b = bh >> 2, h = bh & 3, sc = c / NB, jc = c % NB, row0 = b * 2048 + c * 64;
#ifdef LDSSHIFT
    if (TY != 2) lds += LDSSHIFT;
#endif
    ldsp QX = lds, QH2 = lds + o_qh, KTs = lds + o_kt, VTs = lds + o_vt, Pm = lds + o_pm; LAS float* RED = (LAS float*)(lds + o_red);
    const bf16_t* Pb = (const bf16_t*)(p.ws + WS_P);
    constexpr int PP = TY == 2 ? NO : NE;
    const int ecol = TY ? 256 + h * 128 : h * 64;
    if (TY == 2) stage_rows<DK>(QX, PQ, Pb + (size_t)row0 * NO + O_Q + h * 256, NO, tid);
    else { stage_rows<DK>(QX, PQ, (const bf16_t*)(p.ws + WS_QT) + (size_t)row0 * 768 + ecol, 768, tid);
           stage_rows<DK>(QH2, PQ, (const bf16_t*)(p.ws + WS_QH) + (size_t)row0 * 768 + ecol, 768, tid); }
    f32x4 acc[ET][4];
#pragma unroll
    for (int ei = 0; ei < ET; ++ei)
#pragma unroll
        for (int tk = 0; tk < 4; ++tk) acc[ei][tk] = (f32x4){0.f, 0.f, 0.f, 0.f};
    const int voff = TY == 0 ? E_VA + h * 128 : (TY == 1 ? E_IB + h * 128 : O_V + h * 512);
    const int tt = wave & 3, sp = wave >> 2;
    u32x4 kr[TY == 2 ? 4 : 1], vr[TY == 2 ? 8 : 1];
    if constexpr (TY == 2) { const size_t rowq = (size_t)b * 2048 + (sc * NB) * 64;
        ld_rows<256>(kr, Pb + rowq * NO + O_K + h * 256, NO, tid); ld_T<512>(vr, Pb + rowq * NO + voff, NO, wave, lane); }
    for (int j = 0; j <= jc; ++j) { const size_t rowj = (size_t)b * 2048 + (sc * NB + j) * 64;
        if constexpr (TY == 2) { st_rows<256>(KTs, PQ, kr, tid); st_T<512>(VTs, 72, vr, wave, lane); }
        else { stage_rows<DK>(KTs, PQ, (const bf16_t*)(p.ws + WS_KT) + rowj * 768 + ecol, 768, tid);
               stage_T<DV>(VTs, 72, Pb + rowj * PP + voff, PP, wave, lane); }
        if constexpr (TY == 2) { __syncthreads(); if (j < jc) { const size_t rown = rowj + 64; ld_rows<256>(kr, Pb + rown * NO + O_K + h * 256, NO, tid); ld_T<512>(vr, Pb + rown * NO + voff, NO, wave, lane); } }
        else BSYNC();
        { f32x4 c0 = (f32x4){0.f, 0.f, 0.f, 0.f}, c1 = c0;
#pragma unroll
          for (int ks = 0; ks < DK / 32; ++ks) { const bf16x8 bq = ldfrag(QX, (16 * tt + l15) * PQ + 32 * ks + 8 * q4);
              c0 = mma16(ldfrag(KTs, (16 * (2 * sp) + l15) * PQ + 32 * ks + 8 * q4), bq, c0);
              c1 = mma16(ldfrag(KTs, (16 * (2 * sp + 1) + l15) * PQ + 32 * ks + 8 * q4), bq, c1); }
          const int t = 16 * tt + l15;
          const int tl = (j == jc) ? t : 4096;
#pragma unroll
          for (int jj = 0; jj < 4; ++jj) { if (32 * sp + 4 * q4 + jj > tl) c0[jj] = 0.f; if (32 * sp + 16 + 4 * q4 + jj > tl) c1[jj] = 0.f; }
          u32x2 w; w.x = pk2(c0[0], c0[1]); w.y = pk2(c0[2], c0[3]); *(LAS u32x2*)(Pm + (size_t)(t * 72 + 32 * sp + 4 * q4) * 2) = w;
          w.x = pk2(c1[0], c1[1]); w.y = pk2(c1[2], c1[3]); *(LAS u32x2*)(Pm + (size_t)(t * 72 + 32 * sp + 16 + 4 * q4) * 2) = w; }
        if constexpr (TY == 2) __syncthreads(); else BSYNC();
#pragma unroll
        for (int ks = 0; ks < 2; ++ks) { bf16x8 pb[4];
#pragma unroll
            for (int tk = 0; tk < 4; ++tk) pb[tk] = ldfrag(Pm, (16 * tk + l15) * 72 + 32 * ks + 8 * q4);
#pragma unroll
            for (int ei = 0; ei < ET; ++ei) { const bf16x8 va = ldfrag(VTs, (16 * (wave * ET + ei) + l15) * 72 + 32 * ks + 8 * q4);
#pragma unroll
                for (int tk = 0; tk < 4; ++tk) acc[ei][tk] = mma16(va, pb[tk], acc[ei][tk]); } }
        if constexpr (TY == 2) __syncthreads(); else BSYNC(); }
    if ((TY == 2 ? sc : c) != 0) { const bf16_t* STp = (TY == 2) ? (const bf16_t*)(p.ws + WS_ST) + ((size_t)bh * 8 + sc) * 512 * 256
                                    : (const bf16_t*)(p.ws + WS_ST + (TY ? ST_HGRN : 0)) + ((size_t)bh * 32 + c) * 128 * DK;
      ldsp QS = (TY == 2) ? QX : QH2;
      bf16x8 sa[ET], sn[ET];
#pragma unroll
      for (int ei = 0; ei < ET; ++ei) sa[ei] = *(const bf16x8*)(STp + (size_t)(16 * (wave * ET + ei) + l15) * DK + 8 * q4);
#pragma unroll 1
      for (int ks = 0; ks < DK / 32; ++ks) { bf16x8 qb[4];
          const int kn = (ks + 1 < DK / 32) ? ks + 1 : ks;
#pragma unroll
          for (int ei = 0; ei < ET; ++ei) sn[ei] = *(const bf16x8*)(STp + (size_t)(16 * (wave * ET + ei) + l15) * DK + 32 * kn + 8 * q4);
#pragma unroll
          for (int tk = 0; tk < 4; ++tk) qb[tk] = ldfrag(QS, (16 * tk + l15) * PQ + 32 * ks + 8 * q4);
#pragma unroll
          for (int ei = 0; ei < ET; ++ei) {
#pragma unroll
              for (int tk = 0; tk < 4; ++tk) acc[ei][tk] = mma16(sa[ei], qb[tk], acc[ei][tk]); }
#pragma unroll
          for (int ei = 0; ei < ET; ++ei) sa[ei] = sn[ei]; } }
    if (TY == 2 && (DBGSKIP & 4)) {
#pragma unroll
        for (int ei = 0; ei < ET; ++ei)
#pragma unroll
            for (int tk = 0; tk < 4; ++tk)
#pragma unroll
                for (int jj = 0; jj < 4; ++jj) acc[ei][tk][jj] = (float)((16 * (wave * ET + ei) + 4 * q4 + jj + 3 * (16 * tk + l15) + row0) & 15) - 7.5f;
    }
    float rstd[4];
#pragma unroll
    for (int tk = 0; tk < 4; ++tk) { float s = 0.f;
#pragma unroll
        for (int ei = 0; ei < ET; ++ei) { const f32x4 v = acc[ei][tk]; s += (v[0] * v[0] + v[1] * v[1]) + (v[2] * v[2] + v[3] * v[3]); }
        s += __shfl_xor(s, 16); s += __shfl_xor(s, 32);
        if (q4 == 0) RED[wave * 64 + 16 * tk + l15] = s; }
    BSYNC();
#pragma unroll
    for (int tk = 0; tk < 4; ++tk) { float s = 0.f;
#pragma unroll
        for (int w = 0; w < 8; ++w) s += RED[w * 64 + 16 * tk + l15];
        rstd[tk] = rsqrtf(s * (1.0f / DV) + EPS); }
    const float* nwp = TY == 0 ? p.in[12] : (TY == 1 ? p.in[14] : p.in[17]);
    const int goff = TY == 0 ? E_RA + h * 128 : (TY == 1 ? E_GB + h * 128 : O_G + h * 512);
    constexpr int LDY = TY == 2 ? 2048 : 1024; const int ycol = TY == 0 ? h * 128 : (TY == 1 ? 512 + h * 128 : h * 512);
    bf16_t* Y = (bf16_t*)(p.ws + WS_Y);
#pragma unroll
    for (int ei = 0; ei < ET; ++ei) { const int e0 = 16 * (wave * ET + ei) + 4 * q4; const f32x4 w4 = *(const f32x4*)(nwp + e0);
#pragma unroll
        for (int tk = 0; tk < 4; ++tk) { const size_t row = (size_t)row0 + 16 * tk + l15;
            const u32x2 gw = *(const u32x2*)(Pb + row * PP + goff + e0);
            const float g0 = bf2f(gw.x & 0xffffu), g1 = bf2f(gw.x >> 16), g2 = bf2f(gw.y & 0xffffu), g3 = bf2f(gw.y >> 16);
            const f32x4 v = acc[ei][tk] * rstd[tk] * w4;
            float y0 = v[0] * siluf(g0), y1 = v[1] * siluf(g1), y2 = v[2] * siluf(g2), y3 = v[3] * siluf(g3);
#ifdef NANFIX
            if (!(fabsf(y0) < 1e30f)) y0 = 0.f; if (!(fabsf(y1) < 1e30f)) y1 = 0.f; if (!(fabsf(y2) < 1e30f)) y2 = 0.f; if (!(fabsf(y3) < 1e30f)) y3 = 0.f;
#endif
            u32x2 o; o.x = pk2(y0, y1); o.y = pk2(y2, y3);
            *(u32x2*)(Y + row * LDY + ycol + e0) = o; } }
    BSYNC();
}

template <int TY> __device__ __forceinline__ void sample_item(const Params& p, ldsp lds, int item) {
    constexpr int DK = TY == 0 ? 64 : (TY == 1 ? 128 : 256), DV = TY == 2 ? 512 : 128, E4 = DV / 4, NG = NTHREADS / E4, PP = TY == 2 ? NO : NE;
    const int tid = otid(), lane = tid & 63, wave = __builtin_amdgcn_readfirstlane(tid >> 6);
    const int b = item >> 2, h = item & 3, r0 = MP + b * 8;
    LAS float* QK = (LAS float*)lds; LAS float* Bs = (LAS float*)(lds + 16384); LAS float* QR = (LAS float*)(lds + 24576); LAS float* KR = (LAS float*)(lds + 32768);
    LAS float* DECs = (LAS float*)(lds + 40960); LAS float* As = (LAS float*)(lds + 41984); LAS float* Vs = (LAS float*)(lds + 42240); LAS float* OP = (LAS float*)(lds + 58624);
    static_assert(58624 + 65536 <= LDS_BYTES, "sample LDS");
    const bf16_t* Pb = (const bf16_t*)(p.ws + WS_P) + (size_t)r0 * PP;
    const int voff = TY == 0 ? E_VA + h * 128 : (TY == 1 ? E_IB + h * 128 : O_V + h * 512);
    for (int idx = tid; idx < 8 * DV; idx += NTHREADS) { const int t = idx / DV, e = idx % DV; Vs[idx] = bf2f(Pb[(size_t)t * PP + voff + e]); }
    if (tid < DK) { const int d = tid;
        float w2[16]; float bias = 0.f, lbv = 0.f, lng = 0.f;
        if (TY == 0) {
#pragma unroll
            for (int r = 0; r < 16; ++r) w2[r] = p.in[10][r * 256 + h * 64 + d];
            bias = p.in[11][h * 64 + d];
        } else if (TY == 1) { const float t0 = p.in[13][h * 128 + d], t1 = p.in[13][512 + h * 128 + d], t2 = p.in[13][1024 + h * 128 + d];
            const float mx = fmaxf(t0, fmaxf(t1, t2)); const float e0 = __expf(t0 - mx), e1 = __expf(t1 - mx), e2 = __expf(t2 - mx); lbv = e0 / (e0 + e1 + e2);
        } else lng = __logf(1.0f - exp2f(-5.0f - (float)h));
        float run = 0.f; float bt[8], qv[8], kv[8];
#pragma unroll
        for (int t = 0; t < 8; ++t) { float g;
            if (TY == 0) { float x = bias;
#pragma unroll
                for (int r = 0; r < 16; ++r) x += bf2f(Pb[(size_t)t * NE + E_LR + r]) * w2[r];
                g = logsig(x) * 0.0625f; qv[t] = bf2f(Pb[(size_t)t * NE + E_QA + h * 64 + d]) * 0.125f; kv[t] = bf2f(Pb[(size_t)t * NE + E_KA + h * 64 + d]);
            } else if (TY == 1) { const float xf = bf2f(Pb[(size_t)t * NE + E_FB + h * 128 + d]); const float sig = __builtin_amdgcn_rcpf(1.0f + __expf(-xf));
                g = __logf(lbv + (1.0f - lbv) * sig); kv[t] = (1.0f - lbv) * __builtin_amdgcn_rcpf(1.0f + __expf(xf)); qv[t] = siluf(bf2f(Pb[(size_t)t * NE + E_QB + h * 128 + d]));
            } else { g = lng; qv[t] = bf2f(Pb[(size_t)t * NO + O_Q + h * 256 + d]); kv[t] = bf2f(Pb[(size_t)t * NO + O_K + h * 256 + d]); }
            run += g; bt[t] = run; }
#pragma unroll
        for (int t = 0; t < 8; ++t) { Bs[t * DK + d] = bt[t]; QR[t * DK + d] = qv[t]; KR[t * DK + d] = kv[t];
            QK[d * 16 + t] = qv[t] * __expf(bt[t]); QK[d * 16 + 8 + t] = kv[t] * __expf(run - bt[t]); }
        DECs[d] = __expf(run); }
    BSYNC();
    { const int pq = tid & 63, part = tid >> 6, t = pq >> 3, s = pq & 7;
      float a = 0.f;
      if (s <= t) { for (int d = part; d < DK; d += 8) a += QR[t * DK + d] * KR[s * DK + d] * __expf(Bs[t * DK + d] - Bs[s * DK + d]); }
      OP[part * 64 + pq] = a; }
    BSYNC();
    if (tid < 64) { float a = 0.f;
#pragma unroll
        for (int q = 0; q < 8; ++q) a += OP[q * 64 + tid];
        As[tid] = a; }
    BSYNC();
    const int e4 = tid % E4, dg = tid / E4;
    f32x4 v[8], o[8];
#pragma unroll
    for (int t = 0; t < 8; ++t) { v[t] = *(const LAS f32x4*)(Vs + t * DV + e4 * 4); o[t] = (f32x4){0.f, 0.f, 0.f, 0.f}; }
    const float* S0 = (TY == 0 ? p.in[2] : (TY == 1 ? p.in[3] : p.in[4])) + (size_t)item * DK * DV;
    float* S1 = p.out + (TY == 0 ? OUT_GLA_S : (TY == 1 ? OUT_HGRN_S : OUT_RET_S)) + (size_t)item * DK * DV;
#pragma unroll 16
    for (int d = dg; d < DK; d += NG) { const f32x4 s0 = __builtin_nontemporal_load((const f32x4*)(S0 + (size_t)d * DV + e4 * 4));
        const f32x4 qa = *(const LAS f32x4*)(QK + d * 16), qb = *(const LAS f32x4*)(QK + d * 16 + 4), ka = *(const LAS f32x4*)(QK + d * 16 + 8), kb = *(const LAS f32x4*)(QK + d * 16 + 12);
        const float dc = DECs[d];
        o[0] += s0 * qa[0]; o[1] += s0 * qa[1]; o[2] += s0 * qa[2]; o[3] += s0 * qa[3]; o[4] += s0 * qb[0]; o[5] += s0 * qb[1]; o[6] += s0 * qb[2]; o[7] += s0 * qb[3];
        f32x4 sn = s0 * dc; sn += v[0] * ka[0]; sn += v[1] * ka[1]; sn += v[2] * ka[2]; sn += v[3] * ka[3]; sn += v[4] * kb[0]; sn += v[5] * kb[1]; sn += v[6] * kb[2]; sn += v[7] * kb[3];
        __builtin_nontemporal_store(sn, (f32x4*)(S1 + (size_t)d * DV + e4 * 4)); }
#pragma unroll
    for (int t = 0; t < 8; ++t) *(LAS f32x4*)(OP + (dg * 8 + t) * DV + e4 * 4) = o[t];
    BSYNC();
    { const int t = wave; float val[DV / 64]; float ssq = 0.f;
#pragma unroll
      for (int i = 0; i < DV / 64; ++i) { const int e = lane + 64 * i; float a = 0.f;
          for (int g = 0; g < NG; ++g) a += OP[(g * 8 + t) * DV + e];
          for (int s = 0; s <= t; ++s) a += As[t * 8 + s] * Vs[s * DV + e];
          val[i] = a; ssq += a * a; }
      ssq = wave_sum(ssq); const float rstd = rsqrtf(ssq * (1.0f / DV) + EPS);
      const float* nwp = TY == 0 ? p.in[12] : (TY == 1 ? p.in[14] : p.in[17]);
      const int goff = TY == 0 ? E_RA + h * 128 : (TY == 1 ? E_GB + h * 128 : O_G + h * 512);
      constexpr int LDY = TY == 2 ? 2048 : 1024; const int ycol = TY == 0 ? h * 128 : (TY == 1 ? 512 + h * 128 : h * 512);
      bf16_t* Y = (bf16_t*)(p.ws + WS_Y) + (size_t)(r0 + t) * LDY + ycol;
#pragma unroll
      for (int i = 0; i < DV / 64; ++i) { const int e = lane + 64 * i; const float g = bf2f(Pb[(size_t)t * PP + goff + e]);
          Y[e] = (bf16_t)f2bf(val[i] * rstd * nwp[e] * siluf(g)); } }
    BSYNC();
}

#define XB_TMO      128
#define XB_XCNT(j)  (256  + 64 * (j))
#define XB_XSUB(j)  (1280 + 64 * (j))
#define XB_XGEN(j)  (2304 + 64 * (j))
#define XB_TOP      3328
#define XB_TOPGEN   3392
#define XCD_BAR_WORDS 3456
#define XB_SPIN_CAP (1u << 18)

__device__ __forceinline__ unsigned xb_ld(unsigned* p)              { return __hip_atomic_load(p, __ATOMIC_RELAXED, __HIP_MEMORY_SCOPE_AGENT); }
__device__ __forceinline__ unsigned xb_add(unsigned* p, unsigned v) { return __hip_atomic_fetch_add(p, v, __ATOMIC_RELAXED, __HIP_MEMORY_SCOPE_AGENT); }
__device__ __forceinline__ unsigned xb_xcc_id() { return (unsigned)__builtin_amdgcn_s_getreg((3 << 11) | 20) & 0xFu; }
#define XB_SPIN(cond, bar) do { unsigned _sp = 0; while (cond) { __builtin_amdgcn_s_sleep(1); \
    if ((++_sp & 255u) == 0u) { if (xb_ld(&(bar)[XB_TMO])) break; if (_sp > XB_SPIN_CAP) { atomicAdd(&(bar)[XB_TMO], 1u); break; } } } } while (0)
struct XcdBarrier {
    unsigned* bar; unsigned x;
    volatile LAS unsigned* st;
};

__device__ __forceinline__ XcdBarrier xcd_barrier_post(unsigned* bar, volatile LAS unsigned* st) {
    XcdBarrier b; b.bar = bar; b.x = xb_xcc_id(); b.st = st;
    if (threadIdx.x == 0) (void)xb_add(&bar[XB_XCNT(b.x)], 1u);
    return b;
}
__device__ __forceinline__ void xcd_barrier_complete(unsigned* bar, unsigned x, unsigned& nloc, unsigned& nx) {
    const unsigned G = gridDim.x * gridDim.y * gridDim.z;
    unsigned sum, cnt, mine, sp = 0u;
    for (;;) {
        sum = 0u; cnt = 0u; mine = 0u;
#pragma unroll
        for (unsigned j = 0; j < 16; ++j) { const unsigned c = xb_ld(&bar[XB_XCNT(j)]); sum += c; cnt += (c > 0u) ? 1u : 0u; mine = (j == x) ? c : mine; }
        if (sum == G) break;
        __builtin_amdgcn_s_sleep(1);
        if ((++sp & 255u) == 0u) { if (xb_ld(&bar[XB_TMO])) break; if (sp > XB_SPIN_CAP) { atomicAdd(&bar[XB_TMO], 1u); break; } }
    }
    nloc = mine > 0u ? mine : 1u; nx = cnt > 0u ? cnt : 1u;
}

__device__ __forceinline__ void xcd_barrier(const XcdBarrier& b) {
    asm volatile("s_waitcnt vmcnt(0)" ::: "memory");
    __syncthreads();
    if (threadIdx.x == 0) {
        unsigned* bar = b.bar;
        __builtin_amdgcn_s_waitcnt(0);
        unsigned nloc = b.st[0], nx = b.st[1];
        if (nloc == 0u) { xcd_barrier_complete(bar, b.x, nloc, nx); b.st[0] = nloc; b.st[1] = nx; }
        const unsigned old = xb_add(&bar[XB_XSUB(b.x)], 1u);
        const unsigned gen = old / nloc;
        if (old + 1u == (gen + 1u) * nloc) {
            __builtin_amdgcn_fence(__ATOMIC_RELEASE, "agent");
            asm volatile("s_waitcnt vmcnt(0)" ::: "memory");
            const unsigned og = xb_add(&bar[XB_TOP], 1u);
            const unsigned tg = og / nx;
            if (og + 1u == (tg + 1u) * nx) xb_add(&bar[XB_TOPGEN], 1u);
            else XB_SPIN(xb_ld(&bar[XB_TOPGEN]) == tg, bar);
            __builtin_amdgcn_fence(__ATOMIC_ACQUIRE, "agent");
            xb_add(&bar[XB_XGEN(b.x)], 1u);
            asm volatile("s_waitcnt vmcnt(0)" ::: "memory");
        } else {
            XB_SPIN(xb_ld(&bar[XB_XGEN(b.x)]) == gen, bar);
            __builtin_amdgcn_fence(__ATOMIC_ACQUIRE, "agent");
            asm volatile("s_waitcnt vmcnt(0)" ::: "memory");
        }
    }
    __syncthreads();
}

__device__ __forceinline__ unsigned char* ows(const Params& p) { unsigned char* w = p.ws; asm volatile("" : "+s"(w)); return w; }
__device__ __forceinline__ void gsync(cg::grid_group& grid) {
    asm volatile("s_waitcnt vmcnt(0) lgkmcnt(0)" ::: "memory");
    grid.sync();
    __builtin_amdgcn_fence(__ATOMIC_ACQUIRE, "agent");
    asm volatile("s_waitcnt vmcnt(0)" ::: "memory");
}
__global__ void __launch_bounds__(NTHREADS, 2) fwd_megakernel(Params p) {
    extern __shared__ __attribute__((aligned(16))) unsigned char lds_raw[];
    cg::grid_group grid = cg::this_grid();
    ldsp lds = (ldsp)lds_raw;
    const int G = gridDim.x, bid = blockIdx.x;
    volatile LAS unsigned* xst = (volatile LAS unsigned*)(lds + LDS_BYTES - 16);
    if (threadIdx.x == 0) { xst[0] = 0u; xst[1] = 0u; xst[2] = 0u; xst[3] = 0u; }
    __syncthreads();
    (void)xcd_barrier_post((unsigned*)(p.ws + WS_BAR), xst);
#define XSYNC() do { XcdBarrier xb_; xb_.bar = (unsigned*)(p.ws + WS_BAR); xb_.x = xb_xcc_id(); xb_.st = (volatile LAS unsigned*)(lds + LDS_BYTES - 16); xcd_barrier(xb_); } while (0)

    prologue(p, lds);
#if REP_P0 > 1
    prologue(p, lds);
#endif
    XSYNC();
#pragma unroll 1
    for (int f = 0; f < 4; ++f) { const int l = f >> 1, j = f & 1;
        { unsigned char* ws = ows(p); pg8::Gemm g{(const bf16_t*)(ws + WS_XB), (const bf16_t*)(ws + WS_WUP + f * SZ_WUP), M, NUP, D, D}; pg8::StaticOrder S; S.init(M, NUP, G, bid, TREP_UP);
          pg8::EpiSwiGLU E{(bf16_t*)(ws + WS_ACT), (const float*)(ws + WS_RS)}; pg8::gemm_phase<pg8::EpiSwiGLU, pg8::StaticOrder, true, true>(lds, g, S, E);
#if REP_UP > 1
                  pg8::gemm_phase<pg8::EpiSwiGLU, pg8::StaticOrder, true, true>(lds, g, S, E);
#endif
                }
        XSYNC();
        { unsigned char* ws = ows(p); pg8::Gemm g{(const bf16_t*)(ws + WS_ACT), (const bf16_t*)(ws + WS_WDN + f * SZ_WDN), MP, D, FF, FF}; pg8::StaticOrder S; S.init(MP, D, G, bid, TREP_DN);
          pg8::EpiB16 E{(bf16_t*)(ws + WS_F)}; pg8::gemm_phase<pg8::EpiB16, pg8::StaticOrder, true, true>(lds, g, S, E); }
        { unsigned char* ws = ows(p); pg8::Gemm g{(const bf16_t*)(ws + WS_ACT), (const bf16_t*)(ws + WS_WDN + f * SZ_WDN), M, D, 256, FF}; pg8::SplitOrder S; S.init(11, G, bid);
          pg8::EpiPart E{(float*)(ws + WS_PART)}; pg8::gemm_phase<pg8::EpiPart, pg8::SplitOrder, true, true>(lds, g, S, E); }
        XSYNC();
        if (PHMASK & 8) row_pass(p, f == 3 ? 2 : 1, 0.5f, p.in[5] + (l * 6 + (j ? 5 : 1)) * D, 11);
        if (f == 3) { if (p.ws == nullptr) gsync(grid);     break; }
        XSYNC();
        if (j == 0) {
            if (l == 0) {
                { unsigned char* ws = ows(p); pg8::Gemm g{(const bf16_t*)(ws + WS_XB), (const bf16_t*)(ws + WS_WINE), M, NE, D, D}; pg8::StaticOrder S; S.init(M, NE, G, bid, TREP_IN);
                  pg8::EpiScale E{(bf16_t*)(ws + WS_P), NE, (const float*)(ws + WS_RS)}; pg8::gemm_phase<pg8::EpiScale, pg8::StaticOrder, true, true>(lds, g, S, E);
#if REP_G > 1
                  pg8::gemm_phase<pg8::EpiScale, pg8::StaticOrder, true, true>(lds, g, S, E);
#endif
                }
                XSYNC();
                for (int it = bid; it < 1024; it += G) { if (it < 512) sample_item<0>(p, lds, it); else sample_item<1>(p, lds, it - 512); }
                for (int it = bid; it < 2048; it += G) { if (it < 1024) ma_even_item<0>(p, lds, it); else ma_even_item<1>(p, lds, it - 1024); }
#if REP_ME > 1
                for (int it = bid; it < 2048; it += G) { if (it < 1024) ma_even_item<0>(p, lds, it); else ma_even_item<1>(p, lds, it - 1024); }
#endif
                XSYNC();
                scan_states<64, 128, 32, false>((const bf16_t*)(p.ws + WS_HL), (const float*)(p.ws + WS_DEC), (bf16_t*)(p.ws + WS_ST), p.out + OUT_GLA_P);
#if REP_ME > 1
                scan_states<64, 128, 32, false>((const bf16_t*)(p.ws + WS_HL), (const float*)(p.ws + WS_DEC), (bf16_t*)(p.ws + WS_ST), p.out + OUT_GLA_P);
#endif
                scan_states<128, 128, 32, false>((const bf16_t*)(p.ws + WS_HL + HL_HGRN), (const float*)(p.ws + WS_DEC + DEC_HGRN), (bf16_t*)(p.ws + WS_ST + ST_HGRN), p.out + OUT_HGRN_P);
#if REP_ME > 1
                scan_states<128, 128, 32, false>((const bf16_t*)(p.ws + WS_HL + HL_HGRN), (const float*)(p.ws + WS_DEC + DEC_HGRN), (bf16_t*)(p.ws + WS_ST + ST_HGRN), p.out + OUT_HGRN_P);
#endif
                XSYNC();
                for (int it = bid; it < 2048; it += G) { if (it < 1024) mc_item<0>(p, lds, it); else mc_item<1>(p, lds, it - 1024); }
#if REP_ME > 1
                for (int it = bid; it < 2048; it += G) { if (it < 1024) mc_item<0>(p, lds, it); else mc_item<1>(p, lds, it - 1024); }
#endif
            } else {
                { unsigned char* ws = ows(p); pg8::Gemm g{(const bf16_t*)(ws + WS_XB), (const bf16_t*)(ws + WS_WINO), M, NO, D, D}; pg8::StaticOrder S; S.init(M, NO, G, bid, TREP_IN);
                  pg8::EpiRet E{(bf16_t*)(ws + WS_P), (const float*)(ws + WS_RS), (const float*)(ws + WS_COS), (const float*)(ws + WS_SIN)}; pg8::gemm_phase<pg8::EpiRet, pg8::StaticOrder, true, true>(lds, g, S, E);
#if REP_G > 1
                  pg8::gemm_phase<pg8::EpiRet, pg8::StaticOrder, true, true>(lds, g, S, E);
#endif
                }
                XSYNC();
                for (int it = bid; it < 512; it += G) sample_item<2>(p, lds, it);
                if (G == 256) { const int xq = bid & 7, yq = bid >> 3;
                    for (int k = 0; k < 4; ++k) { const int q = k * 64 + xq * 8 + (yq >> 2); ma_ret_item(p, lds, q * 4 + (yq & 3)); } }
                else for (int it = bid; it < 1024; it += G) ma_ret_item(p, lds, it);
#if REP_OA > 1
                if (G == 256) { const int xq = bid & 7, yq = bid >> 3;
                    for (int k = 0; k < 4; ++k) { const int q = k * 64 + xq * 8 + (yq >> 2); ma_ret_item(p, lds, q * 4 + (yq & 3)); } }
                else for (int it = bid; it < 1024; it += G) ma_ret_item(p, lds, it);
#endif
                XSYNC();
                scan_states<256, 512, 8, true>((const bf16_t*)(p.ws + WS_HL), nullptr, (bf16_t*)(p.ws + WS_ST), p.out + OUT_RET_P);
#if REP_OB > 1
                scan_states<256, 512, 8, true>((const bf16_t*)(p.ws + WS_HL), nullptr, (bf16_t*)(p.ws + WS_ST), p.out + OUT_RET_P);
#endif
                XSYNC();
                if (G == 256) { const int xq = bid & 7, yq = bid >> 3;
                    for (int k = 0; k < 4; ++k) { const int q = k * 64 + xq * 8 + (yq >> 2), jcq = ((yq & 3) + k) & 3; mc_item<2>(p, lds, (q >> 3) * 32 + (q & 7) * 4 + jcq); } }
                else for (int it = bid; it < 1024; it += G) mc_item<2>(p, lds, (it & ~31) | (((it & 31) + (it >> 8)) & 31));
#if REP_OC > 1
                if (G == 256) { const int xq = bid & 7, yq = bid >> 3;
                    for (int k = 0; k < 4; ++k) { const int q = k * 64 + xq * 8 + (yq >> 2), jcq = ((yq & 3) + k) & 3; mc_item<2>(p, lds, (q >> 3) * 32 + (q & 7) * 4 + jcq); } }
                else for (int it = bid; it < 1024; it += G) mc_item<2>(p, lds, (it & ~31) | (((it & 31) + (it >> 8)) & 31));
#endif
            }
            XSYNC();
            { unsigned char* ws = ows(p); const int KO = l == 0 ? 1024 : 2048; pg8::Gemm g{(const bf16_t*)(ws + WS_Y), (const bf16_t*)(ws + (l == 0 ? WS_WOUTE : WS_WOUTO)), MP, D, KO, KO}; pg8::StaticOrder S; S.init(MP, D, G, bid);
              pg8::EpiB16 E{(bf16_t*)(ws + WS_F)}; pg8::gemm_phase<pg8::EpiB16, pg8::StaticOrder, true, true>(lds, g, S, E); }
            { unsigned char* ws = ows(p); const int KO = l == 0 ? 1024 : 2048; pg8::Gemm g{(const bf16_t*)(ws + WS_Y), (const bf16_t*)(ws + (l == 0 ? WS_WOUTE : WS_WOUTO)), M, D, 256, KO}; pg8::SplitOrder S; S.init(KO / 256, G, bid);
              pg8::EpiPart E{(float*)(ws + WS_PART)}; pg8::gemm_phase<pg8::EpiPart, pg8::SplitOrder, true, true>(lds, g, S, E); }
            XSYNC();
            if (PHMASK & 32768) row_pass(p, 1, 1.0f, p.in[5] + (l * 6 + 3) * D, l == 0 ? 4 : 8);
            XSYNC();
        }
    }
}

extern "C" void kernel_launch(void* const* d_in, const int* in_sizes, int n_in, void* d_out, int out_size, void* d_ws, size_t ws_size, hipStream_t stream) {
    static int grid = 0;
    if (grid == 0) {
        if (n_in != 19 || ws_size < WS_END) { fprintf(stderr, "kernel_launch: unexpected n_in %d / ws %zu (need %zu)\n", n_in, ws_size, (size_t)WS_END); grid = -1; return; }
        int dev = 0, cus = 0, per_cu = 0;
        (void)hipGetDevice(&dev); (void)hipDeviceGetAttribute(&cus, hipDeviceAttributeMultiprocessorCount, dev);
        if (hipFuncSetAttribute((const void*)fwd_megakernel, hipFuncAttributeMaxDynamicSharedMemorySize, LDS_BYTES) != hipSuccess) { fprintf(stderr, "kernel_launch: hipFuncSetAttribute failed\n"); grid = -1; return; }
        if (hipOccupancyMaxActiveBlocksPerMultiprocessor(&per_cu, (const void*)fwd_megakernel, NTHREADS, LDS_BYTES) != hipSuccess || per_cu < 1) { fprintf(stderr, "kernel_launch: occupancy query says %d\n", per_cu); per_cu = 1; }
        (void)hipGetLastError();
        grid = cus * per_cu;
    }
    if (grid < 0) return;
    Params p{};
    for (int i = 0; i < 19; ++i) p.in[i] = (const float*)d_in[i];
    p.out = (float*)d_out; p.ws = (unsigned char*)d_ws;
    if (hipMemsetAsync((char*)d_ws + WS_BAR, 0, 16384, stream) != hipSuccess) { fprintf(stderr, "kernel_launch: memset of barrier words failed\n"); return; }
    void* args[] = {&p};
    hipError_t e = hipLaunchCooperativeKernel((const void*)fwd_megakernel, dim3(grid), dim3(NTHREADS), args, LDS_BYTES, stream);
    if (e != hipSuccess) fprintf(stderr, "cooperative launch failed: %s (grid %d)\n", hipGetErrorString(e), grid);
}
```

```cpp
#include <hip/hip_runtime.h>
#include <hip/hip_cooperative_groups.h>
#include <cstdio>
#include <cstdint>
namespace cg = cooperative_groups;
__device__ __forceinline__ int otid() { int t = threadIdx.x; asm volatile("" : "+v"(t)); return t; }

namespace pg8 {
#define PG8_LAS __attribute__((address_space(3)))
typedef unsigned short bf16_t;
typedef short bf16x8 __attribute__((ext_vector_type(8)));
typedef float f32x4 __attribute__((ext_vector_type(4)));
typedef unsigned u32x4 __attribute__((ext_vector_type(4)));
constexpr int BM = 256, BK = 64, HALF = 128, HTB = HALF * BK * 2  , STAGE_BYTES = 8 * HTB, NXCD = 8, WGM = 8;

__host__ __device__ __forceinline__ int lds_byte(int r, int c) { const int st = (r >> 4) * 2 + (c >> 5), rr = r & 15, cc = c & 31, ob = rr * 64 + cc * 2; return st * 1024 + (ob ^ (((ob >> 9) & 1) << 5)); }
__host__ __device__ __forceinline__ void stage_rc(int b, int& R, int& C) { const int st = b / 1024, sb = b % 1024, swz = sb ^ (((sb >> 9) & 1) << 5); R = (st >> 1) * 16 + swz / 64; C = (st & 1) * 32 + (swz % 64) / 2; }
__host__ __device__ __forceinline__ int perm32(int rho) { const int n = rho >> 4, i = rho & 15; return 8 * (i >> 2) + 4 * n + (i & 3); }

struct Unit { int pm, pn, ks; };
struct Gemm { const bf16_t* A; const bf16_t* Bt; int M, N, K, ld; };

struct StaticOrder {
    int nM, nN, nwg, G, c;
    int rep;
    __host__ __device__ void init(int M, int N, int G_, int c_, int rep_ = 1) { nM = M / BM; nN = N / BM; nwg = nM * nN; G = G_; c = c_; rep = rep_; }
    __host__ __device__ bool next(int i, Unit& u) const {
        long L = (long)i * G + c; if (L >= (long)nwg * rep) return false; if (L >= nwg) L -= nwg;
        int wgid = (int)L; { const int q = nwg / NXCD, r = nwg % NXCD, xcd = wgid % NXCD, off = wgid / NXCD; wgid = (xcd < r ? xcd * (q + 1) : r * (q + 1) + (xcd - r) * q) + off; }
        const int nig = WGM * nN, gid = wgid / nig, fm = gid * WGM, gsz = (nM - fm) < WGM ? (nM - fm) : WGM;
        u.pm = fm + ((wgid % nig) % gsz); u.pn = (wgid % nig) / gsz; u.ks = 0; return true;
    }
    __device__ __forceinline__ void a_ready(const Unit&) const {}
    __device__ __forceinline__ void done(const Unit&) const {}
};

__device__ __forceinline__ unsigned cvt_pk_bf16(float lo, float hi) { unsigned r; asm volatile("v_cvt_pk_bf16_f32 %0, %1, %2" : "=v"(r) : "v"(lo), "v"(hi)); return r; }
__device__ __forceinline__ float silu_f(float x) { return x * __builtin_amdgcn_rcpf(1.0f + __expf(-x)); }
constexpr int MPROMPT = 16384;

struct EpiSwiGLU { static constexpr bool PERM = true, AFTER_DRAIN = false;
    bf16_t* O; const float* rs;
    __device__ __forceinline__ void operator()(const f32x4 (&acc)[2][2][4][2], const Unit& u, int wr, int wc, int fr, int fq) const {
        const int row0 = u.pm * BM + wr * 64 + fr, col0 = u.pn * HALF + wc * 32 + 8 * fq;
#pragma unroll
        for (int ai = 0; ai < 2; ++ai)
#pragma unroll
            for (int m = 0; m < 4; ++m) { const int row = row0 + ai * HALF + m * 16; const float s = rs[row];
                const f32x4 g0 = acc[ai][0][m][0] * s, g1 = acc[ai][0][m][1] * s, u0 = acc[ai][1][m][0] * s, u1 = acc[ai][1][m][1] * s;
                u32x4 w;
                w.x = cvt_pk_bf16(silu_f(g0[0]) * u0[0], silu_f(g0[1]) * u0[1]); w.y = cvt_pk_bf16(silu_f(g0[2]) * u0[2], silu_f(g0[3]) * u0[3]);
                w.z = cvt_pk_bf16(silu_f(g1[0]) * u1[0], silu_f(g1[1]) * u1[1]); w.w = cvt_pk_bf16(silu_f(g1[2]) * u1[2], silu_f(g1[3]) * u1[3]);
                *(u32x4*)(O + (size_t)row * 2816 + col0) = w; }
    }
};
struct EpiF32SS { static constexpr bool PERM = false, AFTER_DRAIN = false;
    float* O; float* ss;
    __device__ __forceinline__ void operator()(const f32x4 (&acc)[2][2][4][2], const Unit& u, int wr, int wc, int fr, int fq) const {
        const int row0 = u.pm * BM + wr * 64 + fr, col0 = u.pn * BM + wc * 32 + 4 * fq;
#pragma unroll
        for (int ai = 0; ai < 2; ++ai)
#pragma unroll
            for (int m = 0; m < 4; ++m) { const int row = row0 + ai * HALF + m * 16; float q = 0.f;
#pragma unroll
                for (int bj = 0; bj < 2; ++bj)
#pragma unroll
                    for (int n = 0; n < 2; ++n) { const f32x4 v = acc[ai][bj][m][n]; *(f32x4*)(O + (size_t)row * 1024 + col0 + bj * HALF + n * 16) = v;
                        q += (v[0] * v[0] + v[1] * v[1]) + (v[2] * v[2] + v[3] * v[3]); }
                q += __shfl_xor(q, 16); q += __shfl_xor(q, 32);
                if (fq == 0) ss[(size_t)row * 16 + u.pn * 4 + wc] = q; }
    }
};
struct SplitOrder {
    int S, nun, G, c;
    __host__ __device__ void init(int S_, int G_, int c_) { S = S_; nun = 16 * S_; G = G_; c = c_; }
    __host__ __device__ bool next(int i, Unit& u) const { const int L = i * G + c; if (L >= nun) return false; const int tile = L / S; u.ks = L - tile * S; u.pm = 64 + (tile >> 2); u.pn = tile & 3; return true; }
    __device__ __forceinline__ void a_ready(const Unit&) const {}
    __device__ __forceinline__ void done(const Unit&) const {}
};
struct EpiF32 { static constexpr bool PERM = false, AFTER_DRAIN = false;
    float* O;
    __device__ __forceinline__ void operator()(const f32x4 (&acc)[2][2][4][2], const Unit& u, int wr, int wc, int fr, int fq) const {
        const int row0 = u.pm * BM + wr * 64 + fr, col0 = u.pn * BM + wc * 32 + 4 * fq;
#pragma unroll
        for (int ai = 0; ai < 2; ++ai)
#pragma unroll
            for (int m = 0; m < 4; ++m) { const int row = row0 + ai * HALF + m * 16;
#pragma unroll
                for (int bj = 0; bj < 2; ++bj)
#pragma unroll
                    for (int n = 0; n < 2; ++n) *(f32x4*)(O + (size_t)row * 1024 + col0 + bj * HALF + n * 16) = acc[ai][bj][m][n]; }
    }
};
struct EpiB16 { static constexpr bool PERM = true, AFTER_DRAIN = false;
    bf16_t* O;
    __device__ __forceinline__ void operator()(const f32x4 (&acc)[2][2][4][2], const Unit& u, int wr, int wc, int fr, int fq) const {
        const int row0 = u.pm * BM + wr * 64 + fr, col0 = u.pn * BM + wc * 32 + 8 * fq;
#pragma unroll
        for (int ai = 0; ai < 2; ++ai)
#pragma unroll
            for (int m = 0; m < 4; ++m) { const int row = row0 + ai * HALF + m * 16;
#pragma unroll
                for (int bj = 0; bj < 2; ++bj) { const f32x4 v0 = acc[ai][bj][m][0], v1 = acc[ai][bj][m][1]; u32x4 w;
                    w.x = cvt_pk_bf16(v0[0], v0[1]); w.y = cvt_pk_bf16(v0[2], v0[3]); w.z = cvt_pk_bf16(v1[0], v1[1]); w.w = cvt_pk_bf16(v1[2], v1[3]);
                    *(u32x4*)(O + (size_t)row * 1024 + col0 + bj * HALF) = w; } }
    }
};
struct EpiPart { static constexpr bool PERM = false, AFTER_DRAIN = false;
    float* O;
    __device__ __forceinline__ void operator()(const f32x4 (&acc)[2][2][4][2], const Unit& u, int wr, int wc, int fr, int fq) const {
        const int row0 = (u.pm - 64) * BM + wr * 64 + fr, col0 = u.pn * BM + wc * 32 + 4 * fq;
        float* Ob = O + (size_t)u.ks * 1024 * 1024;
#pragma unroll
        for (int ai = 0; ai < 2; ++ai)
#pragma unroll
            for (int m = 0; m < 4; ++m) { const int row = row0 + ai * HALF + m * 16;
#pragma unroll
                for (int bj = 0; bj < 2; ++bj)
#pragma unroll
                    for (int n = 0; n < 2; ++n) *(f32x4*)(Ob + (size_t)row * 1024 + col0 + bj * HALF + n * 16) = acc[ai][bj][m][n]; }
    }
};
struct EpiScale { static constexpr bool PERM = true, AFTER_DRAIN = false;
    bf16_t* O; int ldc; const float* rs;
    __device__ __forceinline__ void operator()(const f32x4 (&acc)[2][2][4][2], const Unit& u, int wr, int wc, int fr, int fq) const {
        const int row0 = u.pm * BM + wr * 64 + fr, col0 = u.pn * BM + wc * 32 + 8 * fq;
#pragma unroll
        for (int ai = 0; ai < 2; ++ai)
#pragma unroll
            for (int m = 0; m < 4; ++m) { const int row = row0 + ai * HALF + m * 16; const float s = rs[row];
#pragma unroll
                for (int bj = 0; bj < 2; ++bj) { const f32x4 v0 = acc[ai][bj][m][0] * s, v1 = acc[ai][bj][m][1] * s; u32x4 w;
                    w.x = cvt_pk_bf16(v0[0], v0[1]); w.y = cvt_pk_bf16(v0[2], v0[3]); w.z = cvt_pk_bf16(v1[0], v1[1]); w.w = cvt_pk_bf16(v1[2], v1[3]);
                    *(u32x4*)(O + (size_t)row * ldc + col0 + bj * HALF) = w; } }
    }
};
struct EpiRet { static constexpr bool PERM = true, AFTER_DRAIN = false;
    bf16_t* O; const float* rs; const float* cosT; const float* sinT;
    __device__ __forceinline__ void operator()(const f32x4 (&acc)[2][2][4][2], const Unit& u, int wr, int wc, int fr, int fq) const {
        const int row0 = u.pm * BM + wr * 64 + fr, col0 = u.pn * BM + wc * 32 + 8 * fq;
        const bool rot = u.pn < 8; const int hh = u.pn & 3; const bool isk = u.pn >= 4;
        const float l2g = __log2f(1.0f - exp2f(-5.0f - (float)hh));
#pragma unroll
        for (int ai = 0; ai < 2; ++ai)
#pragma unroll
            for (int m = 0; m < 4; ++m) { const int row = row0 + ai * HALF + m * 16; float s = rs[row];
                if (!rot) {
#pragma unroll
                    for (int bj = 0; bj < 2; ++bj) { const f32x4 v0 = acc[ai][bj][m][0] * s, v1 = acc[ai][bj][m][1] * s; u32x4 w;
                        w.x = cvt_pk_bf16(v0[0], v0[1]); w.y = cvt_pk_bf16(v0[2], v0[3]); w.z = cvt_pk_bf16(v1[0], v1[1]); w.w = cvt_pk_bf16(v1[2], v1[3]);
                        *(u32x4*)(O + (size_t)row * 6144 + col0 + bj * HALF) = w; }
                } else {
                    int pi; float sc;
                    if (row < MPROMPT) { const int pos = row & 2047, tau = pos & 255; pi = pos;
                        sc = isk ? exp2f((float)(128 - tau) * l2g) * 0.0625f : exp2f((float)(tau - 128) * l2g); }
                    else { pi = 2048 + (row & 7); sc = isk ? 0.0625f : 1.0f; }
                    s *= sc;
                    const int fi = wc * 32 + 8 * fq;
                    const f32x4 c0 = *(const f32x4*)(cosT + pi * 128 + fi), c1 = *(const f32x4*)(cosT + pi * 128 + fi + 4);
                    const f32x4 s0 = *(const f32x4*)(sinT + pi * 128 + fi), s1 = *(const f32x4*)(sinT + pi * 128 + fi + 4);
                    const f32x4 a0 = acc[ai][0][m][0] * s, a1 = acc[ai][0][m][1] * s, b0 = acc[ai][1][m][0] * s, b1 = acc[ai][1][m][1] * s;
                    const f32x4 p0 = a0 * c0 - b0 * s0, p1 = a1 * c1 - b1 * s1, q0 = a0 * s0 + b0 * c0, q1 = a1 * s1 + b1 * c1;
                    u32x4 w;
                    w.x = cvt_pk_bf16(p0[0], p0[1]); w.y = cvt_pk_bf16(p0[2], p0[3]); w.z = cvt_pk_bf16(p1[0], p1[1]); w.w = cvt_pk_bf16(p1[2], p1[3]);
                    *(u32x4*)(O + (size_t)row * 6144 + col0) = w;
                    w.x = cvt_pk_bf16(q0[0], q0[1]); w.y = cvt_pk_bf16(q0[2], q0[3]); w.z = cvt_pk_bf16(q1[0], q1[1]); w.w = cvt_pk_bf16(q1[2], q1[3]);
                    *(u32x4*)(O + (size_t)row * 6144 + col0 + HALF) = w;
                } }
    }
};

template <class Epi, class Sched, bool ALIGN_EPI = false, bool SP2 = false>
__device__ __forceinline__ void gemm_phase(PG8_LAS unsigned char* lds, const Gemm g, const Sched& S, const Epi& E) {
    const int tid = otid(), wid = __builtin_amdgcn_readfirstlane(tid >> 6), lane = tid & 63, wr = wid >> 2, wc = wid & 3, fr = lane & 15, fq = lane >> 4;
    const int K = g.K, nt = K / BK;
    unsigned voffA[2], voffB[2];
#pragma unroll
    for (int i = 0; i < 2; ++i) { int R, C; stage_rc(tid * 16 + i * 8192, R, C); const int Rb = Epi::PERM ? ((R & ~31) + perm32(R & 31)) : R;
        voffA[i] = (unsigned)(R * g.ld + C) * 2u; voffB[i] = (unsigned)(Rb * g.ld + C) * 2u; }
    const size_t kstep = (size_t)(BK * 2);
    const size_t hstep = (size_t)HALF * g.ld * 2;
    const size_t tstep = 2 * hstep;
    const unsigned ldsw = (unsigned)wid * 1024u;
    const int aoff = lds_byte(wr * 64 + fr, fq * 8), boff = lds_byte(wc * 32 + fr, fq * 8);
#define PG8_SA(b, h) (((b) * 2 + (h)) * HTB)
#define PG8_SB(b, h) ((4 + (b) * 2 + (h)) * HTB)
#define PG8_STAGE(bufoff, gbase, voff) do { _Pragma("unroll") for (int _i = 0; _i < 2; ++_i) \
        __builtin_amdgcn_global_load_lds((const unsigned*)((const char*)(gbase) + (voff)[_i]), (PG8_LAS unsigned*)(lds + (bufoff) + ldsw + _i * 8192), 16, 0, 0); } while (0)
#define PG8_LDA(dst, b, h) do { _Pragma("unroll") for (int m = 0; m < 4; ++m) _Pragma("unroll") for (int k = 0; k < 2; ++k) dst[m][k] = *(const PG8_LAS bf16x8*)(lds + PG8_SA(b, h) + aoff + m * 2048 + k * 1024); } while (0)
#define PG8_LDB(dst, b, h) do { _Pragma("unroll") for (int n = 0; n < 2; ++n) _Pragma("unroll") for (int k = 0; k < 2; ++k) dst[n][k] = *(const PG8_LAS bf16x8*)(lds + PG8_SB(b, h) + boff + n * 2048 + k * 1024); } while (0)
#define PG8_MMA(ai, bj, At, Bt) do { __builtin_amdgcn_s_setprio(1); _Pragma("unroll") for (int m = 0; m < 4; ++m) _Pragma("unroll") for (int n = 0; n < 2; ++n) _Pragma("unroll") for (int k = 0; k < 2; ++k) \
        acc[ai][bj][m][n] = __builtin_amdgcn_mfma_f32_16x16x32_bf16(Bt[n][k], At[m][k], acc[ai][bj][m][n], 0, 0, 0); __builtin_amdgcn_s_setprio(0); } while (0)
#define PG8_WAIT_V(n) asm volatile("s_waitcnt vmcnt(" #n ")" ::: "memory")
#define PG8_WAIT_L(n) asm volatile("s_waitcnt lgkmcnt(" #n ")" ::: "memory")
#define PG8_BAR __builtin_amdgcn_s_barrier()
#define PG8_SCHED __builtin_amdgcn_sched_barrier(0)
    Unit cur, nxt; int ui = 0;
    if (!S.next(0, cur)) return;
    f32x4 acc[2][2][4][2];
#pragma unroll
    for (int a = 0; a < 2; ++a)
#pragma unroll
        for (int b = 0; b < 2; ++b)
#pragma unroll
            for (int m = 0; m < 4; ++m)
#pragma unroll
                for (int n = 0; n < 2; ++n) acc[a][b][m][n] = (f32x4){0.f, 0.f, 0.f, 0.f};
    bf16x8 At[4][2], B0[2][2], B1[2][2];
    const char* cA = (const char*)g.A + (size_t)cur.pm * tstep + (size_t)cur.ks * K * 2; const char* cB = (const char*)g.Bt + (size_t)cur.pn * tstep + (size_t)cur.ks * K * 2;
    S.a_ready(cur);
    if constexpr (SP2) {
        PG8_STAGE(PG8_SB(0, 0), cB, voffB); PG8_STAGE(PG8_SB(0, 1), cB + hstep, voffB); PG8_STAGE(PG8_SA(0, 0), cA, voffA); PG8_STAGE(PG8_SA(0, 1), cA + hstep, voffA);
        if (wr == 1) PG8_BAR;
        PG8_WAIT_V(2); PG8_BAR;
        PG8_STAGE(PG8_SB(1, 0), cB + kstep, voffB); PG8_STAGE(PG8_SA(1, 0), cA + kstep, voffA); PG8_STAGE(PG8_SB(1, 1), cB + hstep + kstep, voffB);
        PG8_WAIT_V(6); PG8_BAR;
    } else {
        PG8_STAGE(PG8_SB(0, 0), cB, voffB); PG8_STAGE(PG8_SA(0, 0), cA, voffA); PG8_STAGE(PG8_SB(0, 1), cB + hstep, voffB); PG8_STAGE(PG8_SA(0, 1), cA + hstep, voffA);
        if (wr == 1) PG8_BAR;
        PG8_WAIT_V(4); PG8_BAR;
        PG8_STAGE(PG8_SB(1, 0), cB + kstep, voffB); PG8_STAGE(PG8_SA(1, 0), cA + kstep, voffA); PG8_STAGE(PG8_SB(1, 1), cB + hstep + kstep, voffB);
        PG8_WAIT_V(6); PG8_BAR;
    }
    for (;;) {
        const bool has_next = S.next(ui + 1, nxt);
        const char* nA = has_next ? (const char*)g.A + (size_t)nxt.pm * tstep + (size_t)nxt.ks * K * 2 : cA; const char* nB = has_next ? (const char*)g.Bt + (size_t)nxt.pn * tstep + (size_t)nxt.ks * K * 2 : cB;
        for (int t = 0; t < nt; t += 2) {
            const bool last = (t == nt - 2);
            const char* a1 = cA + (size_t)(t + 1) * kstep;
            const char* a2 = last ? nA : cA + (size_t)(t + 2) * kstep; const char* b2 = last ? nB : cB + (size_t)(t + 2) * kstep;
            const char* a3 = a2 + kstep; const char* b3 = b2 + kstep;
            if (last && has_next) S.a_ready(nxt);
            if constexpr (SP2) {
            PG8_LDB(B0, 0, 0); PG8_LDB(B1, 0, 1); PG8_SCHED; PG8_LDA(At, 0, 0); PG8_STAGE(PG8_SA(1, 1), a1 + hstep, voffA);
            PG8_WAIT_V(8); PG8_WAIT_L(0); PG8_BAR; PG8_MMA(0, 0, At, B0); PG8_MMA(0, 1, At, B1); PG8_BAR; PG8_SCHED;
            PG8_LDA(At, 0, 1); PG8_STAGE(PG8_SB(0, 0), b2, voffB); PG8_STAGE(PG8_SB(0, 1), b2 + hstep, voffB); PG8_STAGE(PG8_SA(0, 0), a2, voffA);
            PG8_WAIT_V(8); PG8_WAIT_L(0); PG8_BAR; PG8_MMA(1, 0, At, B0); PG8_MMA(1, 1, At, B1); PG8_BAR; PG8_SCHED;
            PG8_LDB(B0, 1, 0); PG8_LDB(B1, 1, 1); PG8_SCHED; PG8_LDA(At, 1, 0); PG8_STAGE(PG8_SA(0, 1), a2 + hstep, voffA);
            PG8_WAIT_V(8); PG8_WAIT_L(0); PG8_BAR; PG8_MMA(0, 0, At, B0); PG8_MMA(0, 1, At, B1); PG8_BAR; PG8_SCHED;
            PG8_LDA(At, 1, 1); PG8_STAGE(PG8_SB(1, 0), b3, voffB); PG8_STAGE(PG8_SB(1, 1), b3 + hstep, voffB); PG8_STAGE(PG8_SA(1, 0), a3, voffA);
            PG8_WAIT_V(8); PG8_WAIT_L(0); PG8_BAR; PG8_MMA(1, 0, At, B0); PG8_MMA(1, 1, At, B1); PG8_BAR; PG8_SCHED;
            } else {
            PG8_LDB(B0, 0, 0); PG8_SCHED; PG8_LDA(At, 0, 0); PG8_STAGE(PG8_SA(1, 1), a1 + hstep, voffA);
            PG8_WAIT_L(8); PG8_BAR; PG8_WAIT_L(0); PG8_MMA(0, 0, At, B0); PG8_BAR; PG8_SCHED;
            PG8_LDB(B1, 0, 1); PG8_STAGE(PG8_SB(0, 0), b2, voffB);
            PG8_BAR; PG8_WAIT_L(0); PG8_MMA(0, 1, At, B1); PG8_BAR;
            PG8_LDA(At, 0, 1); PG8_STAGE(PG8_SA(0, 0), a2, voffA);
            PG8_BAR; PG8_WAIT_L(0); PG8_MMA(1, 0, At, B0); PG8_BAR; PG8_SCHED;
            PG8_STAGE(PG8_SB(0, 1), b2 + hstep, voffB);
            PG8_WAIT_V(6); PG8_BAR; PG8_MMA(1, 1, At, B1); PG8_BAR;
            PG8_LDB(B0, 1, 0); PG8_SCHED; PG8_LDA(At, 1, 0); PG8_STAGE(PG8_SA(0, 1), a2 + hstep, voffA);
            PG8_WAIT_L(8); PG8_BAR; PG8_WAIT_L(0); PG8_MMA(0, 0, At, B0); PG8_BAR; PG8_SCHED;
            PG8_LDB(B1, 1, 1); PG8_STAGE(PG8_SB(1, 0), b3, voffB);
            PG8_BAR; PG8_WAIT_L(0); PG8_MMA(0, 1, At, B1); PG8_BAR;
            PG8_LDA(At, 1, 1); PG8_STAGE(PG8_SA(1, 0), a3, voffA);
            PG8_BAR; PG8_WAIT_L(0); PG8_MMA(1, 0, At, B0); PG8_BAR; PG8_SCHED;
            PG8_STAGE(PG8_SB(1, 1), b3 + hstep, voffB);
            PG8_WAIT_V(6); PG8_BAR; PG8_MMA(1, 1, At, B1); PG8_BAR;
            }
        }
        if constexpr (ALIGN_EPI) { if (wr == 0) PG8_BAR; }
        if constexpr (!Epi::AFTER_DRAIN) { E(acc, cur, wr, wc, fr, fq); S.done(cur); }
        if (!has_next) break;
#pragma unroll
        for (int a = 0; a < 2; ++a)
#pragma unroll
            for (int b = 0; b < 2; ++b)
#pragma unroll
                for (int m = 0; m < 4; ++m)
#pragma unroll
                    for (int n = 0; n < 2; ++n) acc[a][b][m][n] = (f32x4){0.f, 0.f, 0.f, 0.f};
        cur = nxt; cA = nA; cB = nB; ++ui;
        if constexpr (ALIGN_EPI) { if (wr == 1) PG8_BAR; }
    }
    PG8_WAIT_V(0);
    if constexpr (!ALIGN_EPI) { if (wr == 0) PG8_BAR; }
    PG8_BAR;
    if constexpr (Epi::AFTER_DRAIN) { E.fused(acc, cur, wr, wc, fr, fq, lds, wid, lane); S.done(cur); }
#undef PG8_SA
#undef PG8_SB
#undef PG8_STAGE
#undef PG8_LDA
#undef PG8_LDB
#undef PG8_MMA
#undef PG8_WAIT_V
#undef PG8_WAIT_L
#undef PG8_BAR
#undef PG8_SCHED
}
}

#define LAS __attribute__((address_space(3)))
typedef unsigned short bf16_t;
typedef short bf16x8 __attribute__((ext_vector_type(8)));
typedef float f32x4 __attribute__((ext_vector_type(4)));
typedef unsigned u32x4 __attribute__((ext_vector_type(4)));
typedef unsigned u32x2 __attribute__((ext_vector_type(2)));
typedef LAS unsigned char* ldsp;

constexpr int D = 1024, FF = 2816, MP = 16384, MS = 1024, M = MP + MS, NUP = 2 * FF, NE = 3840, NO = 6144;
constexpr float EPS = 1e-6f;
constexpr int E_QA = 0, E_KA = 256, E_VA = 512, E_RA = 1024, E_QB = 1536, E_FB = 2048, E_IB = 2560, E_GB = 3072, E_LR = 3584;
constexpr int O_Q = 0, O_K = 1024, O_V = 2048, O_G = 4096;
constexpr int NTHREADS = 512;
constexpr int LDS_BYTES = 155648;
#ifndef TREP_UP
#define TREP_UP 1
#endif
#ifndef TREP_IN
#define TREP_IN 1
#endif
#ifndef TREP_DN
#define TREP_DN 1
#endif
#ifndef REP_P0
#define REP_P0 1
#endif
#ifndef REP_ME
#define REP_ME 1
#endif
#ifndef REP_MO
#define REP_MO 1
#endif
#ifndef REP_OA
#define REP_OA 1
#endif
#ifndef REP_OB
#define REP_OB 1
#endif
#ifndef REP_OS
#define REP_OS 1
#endif
#ifndef REP_OC
#define REP_OC 1
#endif
#ifndef REP_UP
#define REP_UP 1
#endif
#ifndef REP_G
#define REP_G 1
#endif
#ifndef REP_M
#define REP_M 1
#endif
#ifndef EXTRA_SYNCS
#define EXTRA_SYNCS 0
#endif
#ifndef STOPAT
#define STOPAT 1000
#endif
#ifndef PHMASK
#define PHMASK 0xFFFF
#define DBGSKIP 0
#define NANFIX2 1
#endif

constexpr size_t al256(size_t x) { return (x + 255) & ~(size_t)255; }
constexpr size_t SZ_WUP = (size_t)NUP * D * 2, SZ_WDN = (size_t)D * FF * 2;
constexpr size_t WS_WUP = 0;
constexpr size_t WS_WDN = WS_WUP + 4 * SZ_WUP;
constexpr size_t WS_WINE = WS_WDN + 4 * SZ_WDN;
constexpr size_t WS_WOUTE = WS_WINE + (size_t)NE * D * 2;
constexpr size_t WS_WINO = WS_WOUTE + (size_t)D * D * 2;
constexpr size_t WS_WOUTO = WS_WINO + (size_t)NO * D * 2;
constexpr size_t WS_XB = WS_WOUTO + (size_t)D * 2048 * 2;
constexpr size_t WS_RS = WS_XB + (size_t)M * D * 2;
constexpr size_t WS_SS = WS_RS + al256((size_t)M * 4);
constexpr size_t WS_ACT = WS_SS + al256((size_t)M * 16 * 4);
constexpr size_t WS_F = WS_ACT + (size_t)M * FF * 2;
constexpr size_t WS_P = WS_F + (size_t)M * D * 4;
constexpr size_t WS_Y = WS_P + (size_t)M * NO * 2;
constexpr size_t WS_QT = WS_Y + (size_t)M * 2048 * 2;
constexpr size_t WS_QH = WS_QT + (size_t)MP * 768 * 2;
constexpr size_t WS_KT = WS_QH + (size_t)MP * 768 * 2;
constexpr size_t WS_HL = WS_KT + (size_t)MP * 768 * 2;
constexpr size_t HL_HGRN = (size_t)1024 * 128 * 64 * 4;
constexpr size_t WS_DEC = WS_HL + (size_t)134217728;
constexpr size_t DEC_HGRN = (size_t)1024 * 64 * 4;
constexpr size_t WS_ST = WS_DEC + (size_t)1048576;
constexpr size_t ST_HGRN = (size_t)1024 * 128 * 64 * 2;
constexpr size_t WS_COS = WS_ST + (size_t)67108864;
constexpr size_t WS_SIN = WS_COS + al256((size_t)2056 * 128 * 4);
constexpr size_t WS_BAR = WS_SIN + al256((size_t)2056 * 128 * 4);
constexpr size_t WS_PART = WS_BAR + 16384;
constexpr size_t WS_END = WS_PART + (size_t)11 * 1024 * 1024 * 4;

constexpr size_t OUT_GLA_P = 17825792, OUT_HGRN_P = 18087936, OUT_RET_P = 18612224, OUT_GLA_S = 22806528, OUT_HGRN_S = 27000832, OUT_RET_S = 35389440;

struct Params { const float* in[19]; float* out; unsigned char* ws; };

__device__ __forceinline__ unsigned f2bf(float f) { unsigned u = __builtin_bit_cast(unsigned, f); return (u + 0x7fffu + ((u >> 16) & 1u)) >> 16; }
__device__ __forceinline__ float bf2f(unsigned u) { return __builtin_bit_cast(float, u << 16); }
__device__ __forceinline__ unsigned pk2(float lo, float hi) { return pg8::cvt_pk_bf16(lo, hi); }
__device__ __forceinline__ float siluf(float x) { return x * __builtin_amdgcn_rcpf(1.0f + __expf(-x)); }
__device__ __forceinline__ float wave_sum(float v) {
#pragma unroll
    for (int o = 1; o < 64; o <<= 1) v += __shfl_xor(v, o);
    return v;
}
__device__ __forceinline__ f32x4 mma16(bf16x8 a, bf16x8 b, f32x4 c) { return __builtin_amdgcn_mfma_f32_16x16x32_bf16(a, b, c, 0, 0, 0); }
__device__ __forceinline__ bf16x8 ldfrag(ldsp base, int elem) { return *(const LAS bf16x8*)(base + (size_t)elem * 2); }
__device__ __forceinline__ float logsig(float x) { return fminf(x, 0.f) - __logf(1.0f + __expf(-fabsf(x))); }

template <int F> __device__ __forceinline__ void stage_rows(ldsp dst, int dp, const bf16_t* src, size_t sp, int tid) {
    constexpr int G8 = F / 8;
#pragma unroll
    for (int it = 0; it < (64 * G8) / NTHREADS; ++it) { const int idx = tid + it * NTHREADS; const int s = idx / G8, g = idx % G8;
        const u32x4 w = *(const u32x4*)(src + (size_t)s * sp + g * 8);
        *(LAS u32x4*)(dst + (size_t)(s * dp + g * 8) * 2) = w; }
}
template <int F> __device__ __forceinline__ void stage_T(ldsp dst, int dp_unused, const bf16_t* src, size_t sp, int wave, int lane) {
    const bf16_t* gb = src + (size_t)(32 * (wave & 1) + (lane & 31)) * sp + (2 * (wave >> 1) + (lane >> 5)) * 8;
    ldsp base = dst + (size_t)((2 * (wave >> 1) + (lane >> 5)) * 8 * 72 + 32 * (wave & 1) + (lane & 31)) * 2;
    constexpr int UF = (F / 64 > 2) ? 2 : F / 64;
#pragma unroll UF
    for (int it = 0; it < F / 64; ++it) { const u32x4 w = *(const u32x4*)(gb + 64 * it);
#pragma unroll
        for (int i = 0; i < 4; ++i) {
            *(LAS bf16_t*)(base + (64 * it + 2 * i) * 144) = (bf16_t)(w[i] & 0xffffu);
            *(LAS bf16_t*)(base + (64 * it + 2 * i + 1) * 144) = (bf16_t)(w[i] >> 16); } }
}

template <int F> __device__ __forceinline__ void ld_rows(u32x4 (&r)[(64 * (F / 8)) / NTHREADS], const bf16_t* src, size_t sp, int tid) {
    constexpr int G8 = F / 8;
#pragma unroll
    for (int it = 0; it < (64 * G8) / NTHREADS; ++it) { const int idx = tid + it * NTHREADS; const int s = idx / G8, g = idx % G8; r[it] = *(const u32x4*)(src + (size_t)s * sp + g * 8); }
}
template <int F> __device__ __forceinline__ void st_rows(ldsp dst, int dp, const u32x4 (&r)[(64 * (F / 8)) / NTHREADS], int tid) {
    constexpr int G8 = F / 8;
#pragma unroll
    for (int it = 0; it < (64 * G8) / NTHREADS; ++it) { const int idx = tid + it * NTHREADS; const int s = idx / G8, g = idx % G8; *(LAS u32x4*)(dst + (size_t)(s * dp + g * 8) * 2) = r[it]; }
}
template <int F> __device__ __forceinline__ void ld_T(u32x4 (&r)[F / 64], const bf16_t* src, size_t sp, int wave, int lane) {
    const bf16_t* base = src + (size_t)(32 * (wave & 1) + (lane & 31)) * sp + (2 * (wave >> 1) + (lane >> 5)) * 8;
#pragma unroll
    for (int it = 0; it < F / 64; ++it) r[it] = *(const u32x4*)(base + 64 * it);
}
template <int F> __device__ __forceinline__ void st_T(ldsp dst, int dp_unused, const u32x4 (&r)[F / 64], int wave, int lane) {
    ldsp base = dst + (size_t)((2 * (wave >> 1) + (lane >> 5)) * 8 * 72 + 32 * (wave & 1) + (lane & 31)) * 2;
#pragma unroll
    for (int it = 0; it < F / 64; ++it) { const u32x4 w = r[it];
#pragma unroll
        for (int i = 0; i < 4; ++i) {
            *(LAS bf16_t*)(base + (64 * it + 2 * i) * 144) = (bf16_t)(w[i] & 0xffffu);
            *(LAS bf16_t*)(base + (64 * it + 2 * i + 1) * 144) = (bf16_t)(w[i] >> 16); } }
}
__device__ __forceinline__ void row_pass(const Params& p, int mode, float coef, const float* nw, int nsplit) {
    const int tid = otid(), lane = tid & 63, wave = tid >> 6;
    const int gw = blockIdx.x * 8 + wave, NGW = gridDim.x * 8;
    float* RS = (float*)(p.ws + WS_RS); const bf16_t* Fb = (const bf16_t*)(p.ws + WS_F); bf16_t* XB = (bf16_t*)(p.ws + WS_XB);
    const bool xcd_map = gridDim.x == 256; const int wx = (blockIdx.x >> 3) * 8 + wave;
    for (int it = 0; it < (xcd_map ? 9 : (M + NGW - 1) / NGW); ++it) {
        int r;
        if (xcd_map) { if (it < 8) r = 2048 * (blockIdx.x & 7) + wx + 256 * it; else { r = MP + gw; if (gw >= MS) break; } }
        else { r = gw + it * NGW; if (r >= M) break; }
        u32x2* B2 = (u32x2*)(XB + (size_t)r * D);
        f32x4 v[4];
        if (mode == 0) { const f32x4* s4 = (r < MP) ? (const f32x4*)(p.in[0] + (size_t)r * D) : (const f32x4*)(p.in[1] + (size_t)(r - MP) * D);
#pragma unroll
            for (int j = 0; j < 4; ++j) v[j] = __builtin_nontemporal_load(s4 + 64 * j + lane);
        } else { f32x4 fv[4]; u32x2 xw[4];
#pragma unroll
            for (int j = 0; j < 4; ++j) xw[j] = B2[64 * j + lane];
            if (r < MP) { const u32x2* F2 = (const u32x2*)(Fb + (size_t)r * D);
#pragma unroll
                for (int j = 0; j < 4; ++j) { const u32x2 w = __builtin_nontemporal_load(F2 + 64 * j + lane); fv[j] = (f32x4){bf2f(w.x & 0xffffu), bf2f(w.x >> 16), bf2f(w.y & 0xffffu), bf2f(w.y >> 16)}; }
            } else { const f32x4* P4 = (const f32x4*)(p.ws + WS_PART) + (size_t)(r - MP) * 256;
#pragma unroll
                for (int j = 0; j < 4; ++j) fv[j] = (f32x4){0.f, 0.f, 0.f, 0.f};
                for (int ks = 0; ks < nsplit; ++ks) {
#pragma unroll
                    for (int j = 0; j < 4; ++j) fv[j] += __builtin_nontemporal_load(P4 + (size_t)ks * 262144 + 64 * j + lane); } }
            float q = 0.f;
#pragma unroll
            for (int j = 0; j < 4; ++j) q += (fv[j][0] * fv[j][0] + fv[j][1] * fv[j][1]) + (fv[j][2] * fv[j][2] + fv[j][3] * fv[j][3]);
            q = wave_sum(q);
            const float rstd = rsqrtf(q * (1.0f / D) + EPS) * coef; const f32x4* W4 = (const f32x4*)nw;
#pragma unroll
            for (int j = 0; j < 4; ++j) { const f32x4 xv = (f32x4){bf2f(xw[j].x & 0xffffu), bf2f(xw[j].x >> 16), bf2f(xw[j].y & 0xffffu), bf2f(xw[j].y >> 16)};
                v[j] = xv + fv[j] * W4[64 * j + lane] * rstd; }
        }
        if (mode == 2) { f32x4* X4 = (f32x4*)(p.out + (size_t)r * D);
#pragma unroll
            for (int j = 0; j < 4; ++j) X4[64 * j + lane] = v[j];
        } else {
            float s = 0.f;
#pragma unroll
            for (int j = 0; j < 4; ++j) s += (v[j][0] * v[j][0] + v[j][1] * v[j][1]) + (v[j][2] * v[j][2] + v[j][3] * v[j][3]);
            s = wave_sum(s);
#pragma unroll
            for (int j = 0; j < 4; ++j) { u32x2 w; w.x = pk2(v[j][0], v[j][1]); w.y = pk2(v[j][2], v[j][3]); B2[64 * j + lane] = w; }
            if (lane == 0) RS[r] = rsqrtf(s * (1.0f / D) + EPS);
        }
    }
}

__device__ __forceinline__ int dst_row(int n, int mode) {
    if (mode == 1) return ((n >> 7) << 8) + (n & 127);
    if (mode == 2) return ((n >> 7) << 8) + 128 + (n & 127);
    if (mode == 3) return n < 1536 ? n : (n < 1552 ? n + 2048 : n - 16);
    return n;
}
__device__ __forceinline__ void transpose_item(const float* W, int K, int N, bf16_t* WT, int mode, const float* ksc, LAS float* scr, int item, int lane) {
    const int nblk = (N + 31) / 32, kb = item / nblk, nb = item % nblk, k0 = 64 * kb, n0 = 32 * nb;
    const int nn = n0 + (lane & 31);
    float tv[32];
#pragma unroll
    for (int i = 0; i < 32; ++i) { const int kk = 2 * i + (lane >> 5); tv[i] = (nn < N) ? __builtin_nontemporal_load(W + (size_t)(k0 + kk) * N + nn) : 0.f; }
#pragma unroll
    for (int i = 0; i < 32; ++i) { const int kk = 2 * i + (lane >> 5); float v = tv[i]; if (ksc) v *= ksc[k0 + kk]; scr[kk * 33 + (lane & 31)] = v; }
    asm volatile("s_waitcnt lgkmcnt(0)" ::: "memory");
    const int c = lane & 7;
#pragma unroll
    for (int j = 0; j < 4; ++j) { const int nl = (lane >> 3) + 8 * j; const LAS float* s = scr + (8 * c) * 33 + nl;
        u32x4 o; o.x = pk2(s[0 * 33], s[1 * 33]); o.y = pk2(s[2 * 33], s[3 * 33]); o.z = pk2(s[4 * 33], s[5 * 33]); o.w = pk2(s[6 * 33], s[7 * 33]);
        if (n0 + nl < N) *(u32x4*)(WT + (size_t)dst_row(n0 + nl, mode) * K + k0 + 8 * c) = o; }
    asm volatile("s_waitcnt lgkmcnt(0)" ::: "memory");
}
__device__ __forceinline__ void prologue(const Params& p, ldsp lds) {
    const int tid = otid(), lane = tid & 63, wave = tid >> 6;
    LAS float* scr = (LAS float*)(lds + wave * 16384);
    const int gw = blockIdx.x * 8 + wave, NGW = gridDim.x * 8;
    const float* nw = p.in[5];
    constexpr int I_UP = 16 * 88, I_DN = 44 * 32, I_EI = 16 * 113, I_EO = 16 * 32, I_OI = 16 * 192, I_OO = 32 * 32;
    constexpr int NITEMS = 8 * I_UP + 4 * I_DN + I_EI + I_EO + I_OI + I_OO;
    for (int it = gw; it < NITEMS; it += NGW) {
        int r = it;
        if (r < 8 * I_UP) { const int f = r / (2 * I_UP), rr = r % (2 * I_UP), isup = rr >= I_UP, ii = rr % I_UP; const int l = f >> 1, j = f & 1;
            transpose_item((isup ? p.in[7] : p.in[6]) + (size_t)f * D * FF, D, FF, (bf16_t*)(p.ws + WS_WUP + f * SZ_WUP), isup ? 2 : 1, nw + (l * 6 + (j ? 4 : 0)) * D, scr, ii, lane); continue; }
        r -= 8 * I_UP;
        if (r < 4 * I_DN) { const int f = r / I_DN, ii = r % I_DN;
            transpose_item(p.in[8] + (size_t)f * FF * D, FF, D, (bf16_t*)(p.ws + WS_WDN + f * SZ_WDN), 0, nullptr, scr, ii, lane); continue; }
        r -= 4 * I_DN;
        if (r < I_EI) { transpose_item(p.in[9], D, 3600, (bf16_t*)(p.ws + WS_WINE), 3, nw + 2 * D, scr, r, lane); continue; }
        r -= I_EI;
        if (r < I_EO) { transpose_item(p.in[15], D, D, (bf16_t*)(p.ws + WS_WOUTE), 0, nullptr, scr, r, lane); continue; }
        r -= I_EO;
        if (r < I_OI) { transpose_item(p.in[16], D, NO, (bf16_t*)(p.ws + WS_WINO), 0, nw + 8 * D, scr, r, lane); continue; }
        r -= I_OI;
        transpose_item(p.in[18], 2048, D, (bf16_t*)(p.ws + WS_WOUTO), 0, nullptr, scr, r, lane);
    }
    const int gtid = blockIdx.x * NTHREADS + tid, GT = gridDim.x * NTHREADS;
    { u32x4* z = (u32x4*)(p.ws + WS_WINE + (size_t)3600 * D * 2); for (int i = gtid; i < 240 * D / 8; i += GT) z[i] = (u32x4){0u, 0u, 0u, 0u}; }
    { float* cosT = (float*)(p.ws + WS_COS); float* sinT = (float*)(p.ws + WS_SIN);
      for (int i = gtid; i < 2056 * 128; i += GT) { const int pi = i >> 7, fi = i & 127; const int pos = pi < 2048 ? pi : 16384 + pi - 2048;
          const float inv = powf(10000.0f, -(float)fi / 128.0f); const float ang = (float)pos * inv;
          const double rev = (double)ang * 0.15915494309189533577; const float fr = (float)(rev - rint(rev));
          cosT[i] = __builtin_amdgcn_cosf(fr); sinT[i] = __builtin_amdgcn_sinf(fr); } }
    row_pass(p, 0, 0.f, nullptr, 0);
}

#define BSYNC() do { asm volatile("s_waitcnt vmcnt(0) lgkmcnt(0)" ::: "memory"); __syncthreads(); } while (0)
template <int TY> __device__ __forceinline__ void ma_even_item(const Params& p, ldsp lds, int item) {
    constexpr int DK = TY ? 128 : 64, NSEG = NTHREADS / DK, SEGL = 64 / NSEG;
    const int tid = otid(), lane = tid & 63, wave = __builtin_amdgcn_readfirstlane(tid >> 6), l15 = lane & 15, q4 = lane >> 4;
    const int bh = item >> 5, c = item & 31, b = bh >> 2, h = bh & 3, row0 = b * 2048 + c * 64;
    const int d = tid % DK, sg = tid / DK;
    LAS float* Bl = (LAS float*)lds; LAS float* SEG = (LAS float*)(lds + 32768); LAS float* LRs = (LAS float*)(lds + 36864);
    ldsp KHT = lds + 40960; ldsp VT = lds + 59392;
    const bf16_t* Pb = (const bf16_t*)(p.ws + WS_P) + (size_t)row0 * NE;
    if (TY == 0) { for (int idx = tid; idx < 1024; idx += NTHREADS) LRs[idx] = bf2f(Pb[(size_t)(idx >> 4) * NE + E_LR + (idx & 15)]); }
    stage_T<128>(VT, 72, Pb + (TY ? E_IB : E_VA) + h * 128, NE, wave, lane);
    float w2[16]; float bias = 0.f, lbv = 0.f;
    if (TY == 0) {
#pragma unroll
        for (int r = 0; r < 16; ++r) w2[r] = p.in[10][r * 256 + h * 64 + d];
        bias = p.in[11][h * 64 + d];
    } else { const float t0 = p.in[13][h * 128 + d], t1 = p.in[13][512 + h * 128 + d], t2 = p.in[13][1024 + h * 128 + d];
        const float mx = fmaxf(t0, fmaxf(t1, t2)); const float e0 = __expf(t0 - mx), e1 = __expf(t1 - mx), e2 = __expf(t2 - mx); lbv = e0 / (e0 + e1 + e2); }
    BSYNC();
    float run = 0.f;
#pragma unroll
    for (int i = 0; i < SEGL; ++i) { const int s = sg * SEGL + i; float g;
        if (TY == 0) { float x = bias;
#pragma unroll
            for (int r = 0; r < 16; ++r) x += LRs[s * 16 + r] * w2[r];
            g = logsig(x) * 0.0625f;
        } else { const float x = bf2f(Pb[(size_t)s * NE + E_FB + h * 128 + d]); const float sig = __builtin_amdgcn_rcpf(1.0f + __expf(-x)); g = __logf(lbv + (1.0f - lbv) * sig); }
        run += g; Bl[s * DK + d] = run; }
    SEG[sg * 128 + d] = run;
    BSYNC();
    float off = 0.f, tot = 0.f;
#pragma unroll
    for (int s2 = 0; s2 < NSEG; ++s2) { const float v = SEG[s2 * 128 + d]; if (s2 < sg) off += v; tot += v; }
#pragma unroll
    for (int i = 0; i < SEGL; ++i) Bl[(sg * SEGL + i) * DK + d] += off;
    BSYNC();
    const float bmid = Bl[31 * DK + d], blast = tot;
    bf16_t* QT = (bf16_t*)(p.ws + WS_QT); bf16_t* QH = (bf16_t*)(p.ws + WS_QH); bf16_t* KT = (bf16_t*)(p.ws + WS_KT);
    const int col = TY ? 256 + h * 128 + d : h * 64 + d;
#pragma unroll
    for (int i = 0; i < SEGL; ++i) { const int s = sg * SEGL + i; const float bs = Bl[s * DK + d]; float qv, kv;
        if (TY == 0) { qv = bf2f(Pb[(size_t)s * NE + E_QA + h * 64 + d]) * 0.125f; kv = bf2f(Pb[(size_t)s * NE + E_KA + h * 64 + d]); }
        else { qv = siluf(bf2f(Pb[(size_t)s * NE + E_QB + h * 128 + d])); const float xf = bf2f(Pb[(size_t)s * NE + E_FB + h * 128 + d]); kv = (1.0f - lbv) * __builtin_amdgcn_rcpf(1.0f + __expf(xf)); }
        const size_t g = (size_t)(row0 + s) * 768 + col;
        QT[g] = (bf16_t)f2bf(qv * __expf(fminf(bs - bmid, 80.f))); QH[g] = (bf16_t)f2bf(qv * __expf(bs)); KT[g] = (bf16_t)f2bf(kv * __expf(fminf(bmid - bs, 80.f)));
        *(LAS bf16_t*)(KHT + (size_t)(d * 72 + s) * 2) = (bf16_t)f2bf(kv * __expf(blast - bs)); }
    if (sg == 0) ((float*)(p.ws + WS_DEC + (TY ? DEC_HGRN : 0)))[(size_t)item * DK + d] = __expf(blast);
    BSYNC();
    f32x4 acc[DK / 16];
#pragma unroll
    for (int i = 0; i < DK / 16; ++i) acc[i] = (f32x4){0.f, 0.f, 0.f, 0.f};
#pragma unroll
    for (int ks = 0; ks < 2; ++ks) { const bf16x8 bf = ldfrag(VT, (16 * wave + l15) * 72 + 32 * ks + 8 * q4);
#pragma unroll
        for (int i = 0; i < DK / 16; ++i) acc[i] = mma16(ldfrag(KHT, (16 * i + l15) * 72 + 32 * ks + 8 * q4), bf, acc[i]); }
    bf16_t* HL = (bf16_t*)(p.ws + WS_HL + (TY ? HL_HGRN : 0)) + ((size_t)item * 128 + 16 * wave + l15) * DK;
#pragma unroll
    for (int i = 0; i < DK / 16; ++i) { u32x2 w; w.x = pk2(acc[i][0], acc[i][1]); w.y = pk2(acc[i][2], acc[i][3]); *(u32x2*)(HL + 16 * i + 4 * q4) = w; }
    BSYNC();
}

__device__ __forceinline__ void ma_ret_item(const Params& p, ldsp lds, int item) {
    const int tid = otid(), lane = tid & 63, wave = __builtin_amdgcn_readfirstlane(tid >> 6), l15 = lane & 15, q4 = lane >> 4;
    const int es = item & 3, sc = (item >> 2) & 7, bh = item >> 5, b = bh >> 2, h = bh & 3;
    ldsp KTt = lds; ldsp VTt = lds + 36864;
    const bf16_t* Pb = (const bf16_t*)(p.ws + WS_P);
    f32x4 acc[16];
#pragma unroll
    for (int i = 0; i < 16; ++i) acc[i] = (f32x4){0.f, 0.f, 0.f, 0.f};
    u32x4 kr[4], vr[2];
    { const size_t rowq = (size_t)b * 2048 + (sc * 4) * 64;
      ld_T<256>(kr, Pb + rowq * NO + O_K + h * 256, NO, wave, lane); ld_T<128>(vr, Pb + rowq * NO + O_V + h * 512 + es * 128, NO, wave, lane); }
    for (int j = 0; j < 4; ++j) { const size_t rowj = (size_t)b * 2048 + (sc * 4 + j) * 64;
        st_T<256>(KTt, 72, kr, wave, lane); st_T<128>(VTt, 72, vr, wave, lane);
        __syncthreads();
        if (j < 3) { const size_t rown = rowj + 64; ld_T<256>(kr, Pb + rown * NO + O_K + h * 256, NO, wave, lane); ld_T<128>(vr, Pb + rown * NO + O_V + h * 512 + es * 128, NO, wave, lane); }
#pragma unroll
        for (int ks = 0; ks < 2; ++ks) { const bf16x8 bf = ldfrag(VTt, (16 * wave + l15) * 72 + 32 * ks + 8 * q4);
#pragma unroll
            for (int i = 0; i < 16; ++i) acc[i] = mma16(ldfrag(KTt, (16 * i + l15) * 72 + 32 * ks + 8 * q4), bf, acc[i]); }
        __syncthreads(); }
    bf16_t* HL = (bf16_t*)(p.ws + WS_HL) + (((size_t)bh * 8 + sc) * 512 + es * 128 + 16 * wave + l15) * 256;
#pragma unroll
    for (int i = 0; i < 16; ++i) { u32x2 w; w.x = pk2(acc[i][0], acc[i][1]); w.y = pk2(acc[i][2], acc[i][3]); *(u32x2*)(HL + 16 * i + 4 * q4) = w; }
}

template <int DK, int DV, int NC, bool RET> __device__ __forceinline__ void scan_states(const bf16_t* HL, const float* DEC, bf16_t* ST, float* outp) {
    constexpr int DQ = DK / 4; constexpr int total = 32 * DV * DQ;
    const int tid_ = otid(); const int gtid = blockIdx.x * NTHREADS + tid_, GT = gridDim.x * NTHREADS;
    const bool xm = RET && gridDim.x == 256; const int lt = (blockIdx.x >> 3) * NTHREADS + tid_;
    const int niter = xm ? 8 : (total + GT - 1) / GT;
    for (int it = 0; it < niter; ++it) {
        int dq, e, bh;
        if (xm) { const int j = lt + 16384 * it; bh = (blockIdx.x & 7) + 8 * (j >> 15); const int rem = j & 32767; e = rem >> 6; dq = rem & 63; }
        else { const int idx = gtid + it * GT; if (idx >= total) break; dq = idx % DQ; e = (idx / DQ) % DV; bh = idx / (DQ * DV); }
        f32x4 S = (f32x4){0.f, 0.f, 0.f, 0.f}; float c_st = 1.f, c_dec = 1.f, c_h = 1.f;
        if (RET) { const float l2g = __log2f(1.0f - exp2f(-5.0f - (float)(bh & 3))); c_st = exp2f(129.f * l2g); c_dec = exp2f(256.f * l2g); c_h = exp2f(127.f * l2g); }
#pragma unroll 8
        for (int c = 0; c < NC; ++c) { const size_t base = (((size_t)bh * NC + c) * DV + e) * DK + dq * 4;
            u32x2 w; w.x = pk2(S[0] * c_st, S[1] * c_st); w.y = pk2(S[2] * c_st, S[3] * c_st); *(u32x2*)(ST + base) = w;
            const u32x2 hw = __builtin_nontemporal_load((const u32x2*)(HL + base)); const f32x4 hl = (f32x4){bf2f(hw.x & 0xffffu), bf2f(hw.x >> 16), bf2f(hw.y & 0xffffu), bf2f(hw.y >> 16)};
            f32x4 dec; if (RET) dec = (f32x4){c_dec, c_dec, c_dec, c_dec}; else dec = *(const f32x4*)(DEC + ((size_t)bh * NC + c) * DK + dq * 4);
            S = dec * S + hl * c_h; }
#pragma unroll
        for (int j = 0; j < 4; ++j) outp[((size_t)bh * DK + dq * 4 + j) * DV + e] = S[j];
    }
}

template <int TY> __device__ __forceinline__ void mc_item(const Params& p, ldsp lds, int item) {
    constexpr int DK = TY == 0 ? 64 : (TY == 1 ? 128 : 256), DV = TY == 2 ? 512 : 128, NB = TY == 2 ? 4 : 1, ET = DV / 128, PQ = DK + 8;
    constexpr int szQ = 64 * PQ * 2, o_qh = szQ, o_kt = (TY == 2 ? 1 : 2) * szQ, o_vt = o_kt + szQ, o_pm = o_vt + DV * 144, o_red = o_pm + 64 * 144;
    static_assert(o_red + 2048 <= LDS_BYTES, "mc LDS");
    const int tid = otid(), lane = tid & 63, wave = __builtin_amdgcn_readfirstlane(tid >> 6), l15 = lane & 15, q4 = lane >> 4;
    const int bh = item >> 5, c = item & 31, b = bh >> 2, h = bh & 3, sc = c / NB, jc = c % NB, row0 = b * 2048 + c * 64;
#ifdef LDSSHIFT
    if (TY != 2) lds += LDSSHIFT;
#endif
    ldsp QX = lds, QH2 = lds + o_qh, KTs = lds + o_kt, VTs = lds + o_vt, Pm = lds + o_pm; LAS float* RED = (LAS float*)(lds + o_red);
    const bf16_t* Pb = (const bf16_t*)(p.ws + WS_P);
    constexpr int PP = TY == 2 ? NO : NE;
    const int ecol = TY ? 256 + h * 128 : h * 64;
    if (TY == 2) stage_rows<DK>(QX, PQ, Pb + (size_t)row0 * NO + O_Q + h * 256, NO, tid);
    else { stage_rows<DK>(QX, PQ, (const bf16_t*)(p.ws + WS_QT) + (size_t)row0 * 768 + ecol, 768, tid);
           stage_rows<DK>(QH2, PQ, (const bf16_t*)(p.ws + WS_QH) + (size_t)row0 * 768 + ecol, 768, tid); }
    f32x4 acc[ET][4];
#pragma unroll
    for (int ei = 0; ei < ET; ++ei)
#pragma unroll
        for (int tk = 0; tk < 4; ++tk) acc[ei][tk] = (f32x4){0.f, 0.f, 0.f, 0.f};
    const int voff = TY == 0 ? E_VA + h * 128 : (TY == 1 ? E_IB + h * 128 : O_V + h * 512);
    const int tt = wave & 3, sp = wave >> 2;
    u32x4 kr[TY == 2 ? 4 : 1], vr[TY == 2 ? 8 : 1];
    if constexpr (TY == 2) { const size_t rowq = (size_t)b * 2048 + (sc * NB) * 64;
        ld_rows<256>(kr, Pb + rowq * NO + O_K + h * 256, NO, tid); ld_T<512>(vr, Pb + rowq * NO + voff, NO, wave, lane); }
    for (int j = 0; j <= jc; ++j) { const size_t rowj = (size_t)b * 2048 + (sc * NB + j) * 64;
        if constexpr (TY == 2) { st_rows<256>(KTs, PQ, kr, tid); st_T<512>(VTs, 72, vr, wave, lane); }
        else { stage_rows<DK>(KTs, PQ, (const bf16_t*)(p.ws + WS_KT) + rowj * 768 + ecol, 768, tid);
               stage_T<DV>(VTs, 72, Pb + rowj * PP + voff, PP, wave, lane); }
        if constexpr (TY == 2) { __syncthreads(); if (j < jc) { const size_t rown = rowj + 64; ld_rows<256>(kr, Pb + rown * NO + O_K + h * 256, NO, tid); ld_T<512>(vr, Pb + rown * NO + voff, NO, wave, lane); } }
        else BSYNC();
        { f32x4 c0 = (f32x4){0.f, 0.f, 0.f, 0.f}, c1 = c0;
#pragma unroll
          for (int ks = 0; ks < DK / 32; ++ks) { const bf16x8 bq = ldfrag(QX, (16 * tt + l15) * PQ + 32 * ks + 8 * q4);
              c0 = mma16(ldfrag(KTs, (16 * (2 * sp) + l15) * PQ + 32 * ks + 8 * q4), bq, c0);
              c1 = mma16(ldfrag(KTs, (16 * (2 * sp + 1) + l15) * PQ + 32 * ks + 8 * q4), bq, c1); }
          const int t = 16 * tt + l15;
          const int tl = (j == jc) ? t : 4096;
#pragma unroll
          for (int jj = 0; jj < 4; ++jj) { if (32 * sp + 4 * q4 + jj > tl) c0[jj] = 0.f; if (32 * sp + 16 + 4 * q4 + jj > tl) c1[jj] = 0.f; }
          u32x2 w; w.x = pk2(c0[0], c0[1]); w.y = pk2(c0[2], c0[3]); *(LAS u32x2*)(Pm + (size_t)(t * 72 + 32 * sp + 4 * q4) * 2) = w;
          w.x = pk2(c1[0], c1[1]); w.y = pk2(c1[2], c1[3]); *(LAS u32x2*)(Pm + (size_t)(t * 72 + 32 * sp + 16 + 4 * q4) * 2) = w; }
        if constexpr (TY == 2) __syncthreads(); else BSYNC();
#pragma unroll
        for (int ks = 0; ks < 2; ++ks) { bf16x8 pb[4];
#pragma unroll
            for (int tk = 0; tk < 4; ++tk) pb[tk] = ldfrag(Pm, (16 * tk + l15) * 72 + 32 * ks + 8 * q4);
#pragma unroll
            for (int ei = 0; ei < ET; ++ei) { const bf16x8 va = ldfrag(VTs, (16 * (wave * ET + ei) + l15) * 72 + 32 * ks + 8 * q4);
#pragma unroll
                for (int tk = 0; tk < 4; ++tk) acc[ei][tk] = mma16(va, pb[tk], acc[ei][tk]); } }
        if constexpr (TY == 2) __syncthreads(); else BSYNC(); }
    if ((TY == 2 ? sc : c) != 0) { const bf16_t* STp = (TY == 2) ? (const bf16_t*)(p.ws + WS_ST) + ((size_t)bh * 8 + sc) * 512 * 256
                                    : (const bf16_t*)(p.ws + WS_ST + (TY ? ST_HGRN : 0)) + ((size_t)bh * 32 + c) * 128 * DK;
      ldsp QS = (TY == 2) ? QX : QH2;
      bf16x8 sa[ET], sn[ET];
#pragma unroll
      for (int ei = 0; ei < ET; ++ei) sa[ei] = *(const bf16x8*)(STp + (size_t)(16 * (wave * ET + ei) + l15) * DK + 8 * q4);
#pragma unroll 1
      for (int ks = 0; ks < DK / 32; ++ks) { bf16x8 qb[4];
          const int kn = (ks + 1 < DK / 32) ? ks + 1 : ks;
#pragma unroll
          for (int ei = 0; ei < ET; ++ei) sn[ei] = *(const bf16x8*)(STp + (size_t)(16 * (wave * ET + ei) + l15) * DK + 32 * kn + 8 * q4);
#pragma unroll
          for (int tk = 0; tk < 4; ++tk) qb[tk] = ldfrag(QS, (16 * tk + l15) * PQ + 32 * ks + 8 * q4);
#pragma unroll
          for (int ei = 0; ei < ET; ++ei) {
#pragma unroll
              for (int tk = 0; tk < 4; ++tk) acc[ei][tk] = mma16(sa[ei], qb[tk], acc[ei][tk]); }
#pragma unroll
          for (int ei = 0; ei < ET; ++ei) sa[ei] = sn[ei]; } }
    if (TY == 2 && (DBGSKIP & 4)) {
#pragma unroll
        for (int ei = 0; ei < ET; ++ei)
#pragma unroll
            for (int tk = 0; tk < 4; ++tk)
#pragma unroll
                for (int jj = 0; jj < 4; ++jj) acc[ei][tk][jj] = (float)((16 * (wave * ET + ei) + 4 * q4 + jj + 3 * (16 * tk + l15) + row0) & 15) - 7.5f;
    }
    float rstd[4];
#pragma unroll
    for (int tk = 0; tk < 4; ++tk) { float s = 0.f;
#pragma unroll
        for (int ei = 0; ei < ET; ++ei) { const f32x4 v = acc[ei][tk]; s += (v[0] * v[0] + v[1] * v[1]) + (v[2] * v[2] + v[3] * v[3]); }
        s += __shfl_xor(s, 16); s += __shfl_xor(s, 32);
        if (q4 == 0) RED[wave * 64 + 16 * tk + l15] = s; }
    BSYNC();
#pragma unroll
    for (int tk = 0; tk < 4; ++tk) { float s = 0.f;
#pragma unroll
        for (int w = 0; w < 8; ++w) s += RED[w * 64 + 16 * tk + l15];
        rstd[tk] = rsqrtf(s * (1.0f / DV) + EPS); }
    const float* nwp = TY == 0 ? p.in[12] : (TY == 1 ? p.in[14] : p.in[17]);
    const int goff = TY == 0 ? E_RA + h * 128 : (TY == 1 ? E_GB + h * 128 : O_G + h * 512);
    constexpr int LDY = TY == 2 ? 2048 : 1024; const int ycol = TY == 0 ? h * 128 : (TY == 1 ? 512 + h * 128 : h * 512);
    bf16_t* Y = (bf16_t*)(p.ws + WS_Y);
#pragma unroll
    for (int ei = 0; ei < ET; ++ei) { const int e0 = 16 * (wave * ET + ei) + 4 * q4; const f32x4 w4 = *(const f32x4*)(nwp + e0);
#pragma unroll
        for (int tk = 0; tk < 4; ++tk) { const size_t row = (size_t)row0 + 16 * tk + l15;
            const u32x2 gw = *(const u32x2*)(Pb + row * PP + goff + e0);
            const float g0 = bf2f(gw.x & 0xffffu), g1 = bf2f(gw.x >> 16), g2 = bf2f(gw.y & 0xffffu), g3 = bf2f(gw.y >> 16);
            const f32x4 v = acc[ei][tk] * rstd[tk] * w4;
            float y0 = v[0] * siluf(g0), y1 = v[1] * siluf(g1), y2 = v[2] * siluf(g2), y3 = v[3] * siluf(g3);
#ifdef NANFIX
            if (!(fabsf(y0) < 1e30f)) y0 = 0.f; if (!(fabsf(y1) < 1e30f)) y1 = 0.f; if (!(fabsf(y2) < 1e30f)) y2 = 0.f; if (!(fabsf(y3) < 1e30f)) y3 = 0.f;
#endif
            u32x2 o; o.x = pk2(y0, y1); o.y = pk2(y2, y3);
            *(u32x2*)(Y + row * LDY + ycol + e0) = o; } }
    BSYNC();
}

template <int TY> __device__ __forceinline__ void sample_item(const Params& p, ldsp lds, int item) {
    constexpr int DK = TY == 0 ? 64 : (TY == 1 ? 128 : 256), DV = TY == 2 ? 512 : 128, E4 = DV / 4, NG = NTHREADS / E4, PP = TY == 2 ? NO : NE;
    const int tid = otid(), lane = tid & 63, wave = __builtin_amdgcn_readfirstlane(tid >> 6);
    const int b = item >> 2, h = item & 3, r0 = MP + b * 8;
    LAS float* QK = (LAS float*)lds; LAS float* Bs = (LAS float*)(lds + 16384); LAS float* QR = (LAS float*)(lds + 24576); LAS float* KR = (LAS float*)(lds + 32768);
    LAS float* DECs = (LAS float*)(lds + 40960); LAS float* As = (LAS float*)(lds + 41984); LAS float* Vs = (LAS float*)(lds + 42240); LAS float* OP = (LAS float*)(lds + 58624);
    static_assert(58624 + 65536 <= LDS_BYTES, "sample LDS");
    const bf16_t* Pb = (const bf16_t*)(p.ws + WS_P) + (size_t)r0 * PP;
    const int voff = TY == 0 ? E_VA + h * 128 : (TY == 1 ? E_IB + h * 128 : O_V + h * 512);
    for (int idx = tid; idx < 8 * DV; idx += NTHREADS) { const int t = idx / DV, e = idx % DV; Vs[idx] = bf2f(Pb[(size_t)t * PP + voff + e]); }
    if (tid < DK) { const int d = tid;
        float w2[16]; float bias = 0.f, lbv = 0.f, lng = 0.f;
        if (TY == 0) {
#pragma unroll
            for (int r = 0; r < 16; ++r) w2[r] = p.in[10][r * 256 + h * 64 + d];
            bias = p.in[11][h * 64 + d];
        } else if (TY == 1) { const float t0 = p.in[13][h * 128 + d], t1 = p.in[13][512 + h * 128 + d], t2 = p.in[13][1024 + h * 128 + d];
            const float mx = fmaxf(t0, fmaxf(t1, t2)); const float e0 = __expf(t0 - mx), e1 = __expf(t1 - mx), e2 = __expf(t2 - mx); lbv = e0 / (e0 + e1 + e2);
        } else lng = __logf(1.0f - exp2f(-5.0f - (float)h));
        float run = 0.f; float bt[8], qv[8], kv[8];
#pragma unroll
        for (int t = 0; t < 8; ++t) { float g;
            if (TY == 0) { float x = bias;
#pragma unroll
                for (int r = 0; r < 16; ++r) x += bf2f(Pb[(size_t)t * NE + E_LR + r]) * w2[r];
                g = logsig(x) * 0.0625f; qv[t] = bf2f(Pb[(size_t)t * NE + E_QA + h * 64 + d]) * 0.125f; kv[t] = bf2f(Pb[(size_t)t * NE + E_KA + h * 64 + d]);
            } else if (TY == 1) { const float xf = bf2f(Pb[(size_t)t * NE + E_FB + h * 128 + d]); const float sig = __builtin_amdgcn_rcpf(1.0f + __expf(-xf));
                g = __logf(lbv + (1.0f - lbv) * sig); kv[t] = (1.0f - lbv) * __builtin_amdgcn_rcpf(1.0f + __expf(xf)); qv[t] = siluf(bf2f(Pb[(size_t)t * NE + E_QB + h * 128 + d]));
            } else { g = lng; qv[t] = bf2f(Pb[(size_t)t * NO + O_Q + h * 256 + d]); kv[t] = bf2f(Pb[(size_t)t * NO + O_K + h * 256 + d]); }
            run += g; bt[t] = run; }
#pragma unroll
        for (int t = 0; t < 8; ++t) { Bs[t * DK + d] = bt[t]; QR[t * DK + d] = qv[t]; KR[t * DK + d] = kv[t];
            QK[d * 16 + t] = qv[t] * __expf(bt[t]); QK[d * 16 + 8 + t] = kv[t] * __expf(run - bt[t]); }
        DECs[d] = __expf(run); }
    BSYNC();
    { const int pq = tid & 63, part = tid >> 6, t = pq >> 3, s = pq & 7;
      float a = 0.f;
      if (s <= t) { for (int d = part; d < DK; d += 8) a += QR[t * DK + d] * KR[s * DK + d] * __expf(Bs[t * DK + d] - Bs[s * DK + d]); }
      OP[part * 64 + pq] = a; }
    BSYNC();
    if (tid < 64) { float a = 0.f;
#pragma unroll
        for (int q = 0; q < 8; ++q) a += OP[q * 64 + tid];
        As[tid] = a; }
    BSYNC();
    const int e4 = tid % E4, dg = tid / E4;
    f32x4 v[8], o[8];
#pragma unroll
    for (int t = 0; t < 8; ++t) { v[t] = *(const LAS f32x4*)(Vs + t * DV + e4 * 4); o[t] = (f32x4){0.f, 0.f, 0.f, 0.f}; }
    const float* S0 = (TY == 0 ? p.in[2] : (TY == 1 ? p.in[3] : p.in[4])) + (size_t)item * DK * DV;
    float* S1 = p.out + (TY == 0 ? OUT_GLA_S : (TY == 1 ? OUT_HGRN_S : OUT_RET_S)) + (size_t)item * DK * DV;
#pragma unroll 8
    for (int d = dg; d < DK; d += NG) { const f32x4 s0 = __builtin_nontemporal_load((const f32x4*)(S0 + (size_t)d * DV + e4 * 4));
        const f32x4 qa = *(const LAS f32x4*)(QK + d * 16), qb = *(const LAS f32x4*)(QK + d * 16 + 4), ka = *(const LAS f32x4*)(QK + d * 16 + 8), kb = *(const LAS f32x4*)(QK + d * 16 + 12);
        const float dc = DECs[d];
        o[0] += s0 * qa[0]; o[1] += s0 * qa[1]; o[2] += s0 * qa[2]; o[3] += s0 * qa[3]; o[4] += s0 * qb[0]; o[5] += s0 * qb[1]; o[6] += s0 * qb[2]; o[7] += s0 * qb[3];
        f32x4 sn = s0 * dc; sn += v[0] * ka[0]; sn += v[1] * ka[1]; sn += v[2] * ka[2]; sn += v[3] * ka[3]; sn += v[4] * kb[0]; sn += v[5] * kb[1]; sn += v[6] * kb[2]; sn += v[7] * kb[3];
        __builtin_nontemporal_store(sn, (f32x4*)(S1 + (size_t)d * DV + e4 * 4)); }
#pragma unroll
    for (int t = 0; t < 8; ++t) *(LAS f32x4*)(OP + (dg * 8 + t) * DV + e4 * 4) = o[t];
    BSYNC();
    { const int t = wave; float val[DV / 64]; float ssq = 0.f;
#pragma unroll
      for (int i = 0; i < DV / 64; ++i) { const int e = lane + 64 * i; float a = 0.f;
          for (int g = 0; g < NG; ++g) a += OP[(g * 8 + t) * DV + e];
          for (int s = 0; s <= t; ++s) a += As[t * 8 + s] * Vs[s * DV + e];
          val[i] = a; ssq += a * a; }
      ssq = wave_sum(ssq); const float rstd = rsqrtf(ssq * (1.0f / DV) + EPS);
      const float* nwp = TY == 0 ? p.in[12] : (TY == 1 ? p.in[14] : p.in[17]);
      const int goff = TY == 0 ? E_RA + h * 128 : (TY == 1 ? E_GB + h * 128 : O_G + h * 512);
      constexpr int LDY = TY == 2 ? 2048 : 1024; const int ycol = TY == 0 ? h * 128 : (TY == 1 ? 512 + h * 128 : h * 512);
      bf16_t* Y = (bf16_t*)(p.ws + WS_Y) + (size_t)(r0 + t) * LDY + ycol;
#pragma unroll
      for (int i = 0; i < DV / 64; ++i) { const int e = lane + 64 * i; const float g = bf2f(Pb[(size_t)t * PP + goff + e]);
          Y[e] = (bf16_t)f2bf(val[i] * rstd * nwp[e] * siluf(g)); } }
    BSYNC();
}

#define XB_TMO      128
#define XB_XCNT(j)  (256  + 64 * (j))
#define XB_XSUB(j)  (1280 + 64 * (j))
#define XB_XGEN(j)  (2304 + 64 * (j))
#define XB_TOP      3328
#define XB_TOPGEN   3392
#define XCD_BAR_WORDS 3456
#define XB_SPIN_CAP (1u << 18)

__device__ __forceinline__ unsigned xb_ld(unsigned* p)              { return __hip_atomic_load(p, __ATOMIC_RELAXED, __HIP_MEMORY_SCOPE_AGENT); }
__device__ __forceinline__ unsigned xb_add(unsigned* p, unsigned v) { return __hip_atomic_fetch_add(p, v, __ATOMIC_RELAXED, __HIP_MEMORY_SCOPE_AGENT); }
__device__ __forceinline__ unsigned xb_xcc_id() { return (unsigned)__builtin_amdgcn_s_getreg((3 << 11) | 20) & 0xFu; }
#define XB_SPIN(cond, bar) do { unsigned _sp = 0; while (cond) { __builtin_amdgcn_s_sleep(1); \
    if ((++_sp & 255u) == 0u) { if (xb_ld(&(bar)[XB_TMO])) break; if (_sp > XB_SPIN_CAP) { atomicAdd(&(bar)[XB_TMO], 1u); break; } } } } while (0)
struct XcdBarrier {
    unsigned* bar; unsigned x;
    volatile LAS unsigned* st;
};

__device__ __forceinline__ XcdBarrier xcd_barrier_post(unsigned* bar, volatile LAS unsigned* st) {
    XcdBarrier b; b.bar = bar; b.x = xb_xcc_id(); b.st = st;
    if (threadIdx.x == 0) (void)xb_add(&bar[XB_XCNT(b.x)], 1u);
    return b;
}
__device__ __forceinline__ void xcd_barrier_complete(unsigned* bar, unsigned x, unsigned& nloc, unsigned& nx) {
    const unsigned G = gridDim.x * gridDim.y * gridDim.z;
    unsigned sum, cnt, mine, sp = 0u;
    for (;;) {
        sum = 0u; cnt = 0u; mine = 0u;
#pragma unroll
        for (unsigned j = 0; j < 16; ++j) { const unsigned c = xb_ld(&bar[XB_XCNT(j)]); sum += c; cnt += (c > 0u) ? 1u : 0u; mine = (j == x) ? c : mine; }
        if (sum == G) break;
        __builtin_amdgcn_s_sleep(1);
        if ((++sp & 255u) == 0u) { if (xb_ld(&bar[XB_TMO])) break; if (sp > XB_SPIN_CAP) { atomicAdd(&bar[XB_TMO], 1u); break; } }
    }
    nloc = mine > 0u ? mine : 1u; nx = cnt > 0u ? cnt : 1u;
}

__device__ __forceinline__ void xcd_barrier(const XcdBarrier& b) {
    asm volatile("s_waitcnt vmcnt(0)" ::: "memory");
    __syncthreads();
    if (threadIdx.x == 0) {
        unsigned* bar = b.bar;
        __builtin_amdgcn_s_waitcnt(0);
        unsigned nloc = b.st[0], nx = b.st[1];
        if (nloc == 0u) { xcd_barrier_complete(bar, b.x, nloc, nx); b.st[0] = nloc; b.st[1] = nx; }
        const unsigned old = xb_add(&bar[XB_XSUB(b.x)], 1u);
        const unsigned gen = old / nloc;
        if (old + 1u == (gen + 1u) * nloc) {
            __builtin_amdgcn_fence(__ATOMIC_RELEASE, "agent");
            asm volatile("s_waitcnt vmcnt(0)" ::: "memory");
            const unsigned og = xb_add(&bar[XB_TOP], 1u);
            const unsigned tg = og / nx;
            if (og + 1u == (tg + 1u) * nx) xb_add(&bar[XB_TOPGEN], 1u);
            else XB_SPIN(xb_ld(&bar[XB_TOPGEN]) == tg, bar);
            __builtin_amdgcn_fence(__ATOMIC_ACQUIRE, "agent");
            xb_add(&bar[XB_XGEN(b.x)], 1u);
            asm volatile("s_waitcnt vmcnt(0)" ::: "memory");
        } else {
            XB_SPIN(xb_ld(&bar[XB_XGEN(b.x)]) == gen, bar);
            __builtin_amdgcn_fence(__ATOMIC_ACQUIRE, "agent");
            asm volatile("s_waitcnt vmcnt(0)" ::: "memory");
        }
    }
    __syncthreads();
}

__device__ __forceinline__ unsigned char* ows(const Params& p) { unsigned char* w = p.ws; asm volatile("" : "+s"(w)); return w; }
__device__ __forceinline__ void gsync(cg::grid_group& grid) {
    asm volatile("s_waitcnt vmcnt(0) lgkmcnt(0)" ::: "memory");
    grid.sync();
    __builtin_amdgcn_fence(__ATOMIC_ACQUIRE, "agent");
    asm volatile("s_waitcnt vmcnt(0)" ::: "memory");
}
__global__ void __launch_bounds__(NTHREADS, 2) fwd_megakernel(Params p) {
    extern __shared__ __attribute__((aligned(16))) unsigned char lds_raw[];
    cg::grid_group grid = cg::this_grid();
    ldsp lds = (ldsp)lds_raw;
    const int G = gridDim.x, bid = blockIdx.x;
    volatile LAS unsigned* xst = (volatile LAS unsigned*)(lds + LDS_BYTES - 16);
    if (threadIdx.x == 0) { xst[0] = 0u; xst[1] = 0u; xst[2] = 0u; xst[3] = 0u; }
    __syncthreads();
    (void)xcd_barrier_post((unsigned*)(p.ws + WS_BAR), xst);
#define XSYNC() do { XcdBarrier xb_; xb_.bar = (unsigned*)(p.ws + WS_BAR); xb_.x = xb_xcc_id(); xb_.st = (volatile LAS unsigned*)(lds + LDS_BYTES - 16); xcd_barrier(xb_); } while (0)

    prologue(p, lds);
#if REP_P0 > 1
    prologue(p, lds);
#endif
    XSYNC();
#pragma unroll 1
    for (int f = 0; f < 4; ++f) { const int l = f >> 1, j = f & 1;
        { unsigned char* ws = ows(p); pg8::Gemm g{(const bf16_t*)(ws + WS_XB), (const bf16_t*)(ws + WS_WUP + f * SZ_WUP), M, NUP, D, D}; pg8::StaticOrder S; S.init(M, NUP, G, bid, TREP_UP);
          pg8::EpiSwiGLU E{(bf16_t*)(ws + WS_ACT), (const float*)(ws + WS_RS)}; pg8::gemm_phase<pg8::EpiSwiGLU, pg8::StaticOrder, true, true>(lds, g, S, E);
#if REP_UP > 1
                  pg8::gemm_phase<pg8::EpiSwiGLU, pg8::StaticOrder, true, true>(lds, g, S, E);
#endif
                }
        XSYNC();
        { unsigned char* ws = ows(p); pg8::Gemm g{(const bf16_t*)(ws + WS_ACT), (const bf16_t*)(ws + WS_WDN + f * SZ_WDN), MP, D, FF, FF}; pg8::StaticOrder S; S.init(MP, D, G, bid, TREP_DN);
          pg8::EpiB16 E{(bf16_t*)(ws + WS_F)}; pg8::gemm_phase<pg8::EpiB16, pg8::StaticOrder, true, true>(lds, g, S, E); }
        { unsigned char* ws = ows(p); pg8::Gemm g{(const bf16_t*)(ws + WS_ACT), (const bf16_t*)(ws + WS_WDN + f * SZ_WDN), M, D, 256, FF}; pg8::SplitOrder S; S.init(11, G, bid);
          pg8::EpiPart E{(float*)(ws + WS_PART)}; pg8::gemm_phase<pg8::EpiPart, pg8::SplitOrder, true, true>(lds, g, S, E); }
        XSYNC();
        if (PHMASK & 8) row_pass(p, f == 3 ? 2 : 1, 0.5f, p.in[5] + (l * 6 + (j ? 5 : 1)) * D, 11);
        if (f == 3) { if (p.ws == nullptr) gsync(grid);     break; }
        XSYNC();
        if (j == 0) {
            if (l == 0) {
                { unsigned char* ws = ows(p); pg8::Gemm g{(const bf16_t*)(ws + WS_XB), (const bf16_t*)(ws + WS_WINE), M, NE, D, D}; pg8::StaticOrder S; S.init(M, NE, G, bid, TREP_IN);
                  pg8::EpiScale E{(bf16_t*)(ws + WS_P), NE, (const float*)(ws + WS_RS)}; pg8::gemm_phase<pg8::EpiScale, pg8::StaticOrder, true, true>(lds, g, S, E);
#if REP_G > 1
                  pg8::gemm_phase<pg8::EpiScale, pg8::StaticOrder, true, true>(lds, g, S, E);
#endif
                }
                XSYNC();
                for (int it = bid; it < 1024; it += G) { if (it < 512) sample_item<0>(p, lds, it); else sample_item<1>(p, lds, it - 512); }
                for (int it = bid; it < 2048; it += G) { if (it < 1024) ma_even_item<0>(p, lds, it); else ma_even_item<1>(p, lds, it - 1024); }
#if REP_ME > 1
                for (int it = bid; it < 2048; it += G) { if (it < 1024) ma_even_item<0>(p, lds, it); else ma_even_item<1>(p, lds, it - 1024); }
#endif
                XSYNC();
                scan_states<64, 128, 32, false>((const bf16_t*)(p.ws + WS_HL), (const float*)(p.ws + WS_DEC), (bf16_t*)(p.ws + WS_ST), p.out + OUT_GLA_P);
#if REP_ME > 1
                scan_states<64, 128, 32, false>((const bf16_t*)(p.ws + WS_HL), (const float*)(p.ws + WS_DEC), (bf16_t*)(p.ws + WS_ST), p.out + OUT_GLA_P);
#endif
                scan_states<128, 128, 32, false>((const bf16_t*)(p.ws + WS_HL + HL_HGRN), (const float*)(p.ws + WS_DEC + DEC_HGRN), (bf16_t*)(p.ws + WS_ST + ST_HGRN), p.out + OUT_HGRN_P);
#if REP_ME > 1
                scan_states<128, 128, 32, false>((const bf16_t*)(p.ws + WS_HL + HL_HGRN), (const float*)(p.ws + WS_DEC + DEC_HGRN), (bf16_t*)(p.ws + WS_ST + ST_HGRN), p.out + OUT_HGRN_P);
#endif
                XSYNC();
                for (int it = bid; it < 2048; it += G) { if (it < 1024) mc_item<0>(p, lds, it); else mc_item<1>(p, lds, it - 1024); }
#if REP_ME > 1
                for (int it = bid; it < 2048; it += G) { if (it < 1024) mc_item<0>(p, lds, it); else mc_item<1>(p, lds, it - 1024); }
#endif
            } else {
                { unsigned char* ws = ows(p); pg8::Gemm g{(const bf16_t*)(ws + WS_XB), (const bf16_t*)(ws + WS_WINO), M, NO, D, D}; pg8::StaticOrder S; S.init(M, NO, G, bid, TREP_IN);
                  pg8::EpiRet E{(bf16_t*)(ws + WS_P), (const float*)(ws + WS_RS), (const float*)(ws + WS_COS), (const float*)(ws + WS_SIN)}; pg8::gemm_phase<pg8::EpiRet, pg8::StaticOrder, true, true>(lds, g, S, E);
#if REP_G > 1
                  pg8::gemm_phase<pg8::EpiRet, pg8::StaticOrder, true, true>(lds, g, S, E);
#endif
                }
                XSYNC();
                for (int it = bid; it < 512; it += G) sample_item<2>(p, lds, it);
                if (G == 256) { const int xq = bid & 7, yq = bid >> 3;
                    for (int k = 0; k < 4; ++k) { const int q = k * 64 + xq * 8 + (yq >> 2); ma_ret_item(p, lds, q * 4 + (yq & 3)); } }
                else for (int it = bid; it < 1024; it += G) ma_ret_item(p, lds, it);
#if REP_OA > 1
                if (G == 256) { const int xq = bid & 7, yq = bid >> 3;
                    for (int k = 0; k < 4; ++k) { const int q = k * 64 + xq * 8 + (yq >> 2); ma_ret_item(p, lds, q * 4 + (yq & 3)); } }
                else for (int it = bid; it < 1024; it += G) ma_ret_item(p, lds, it);
#endif
                XSYNC();
                scan_states<256, 512, 8, true>((const bf16_t*)(p.ws + WS_HL), nullptr, (bf16_t*)(p.ws + WS_ST), p.out + OUT_RET_P);
#if REP_OB > 1
                scan_states<256, 512, 8, true>((const bf16_t*)(p.ws + WS_HL), nullptr, (bf16_t*)(p.ws + WS_ST), p.out + OUT_RET_P);
#endif
                XSYNC();
                if (G == 256) { const int xq = bid & 7, yq = bid >> 3;
                    for (int k = 0; k < 4; ++k) { const int q = k * 64 + xq * 8 + (yq >> 2), jcq = ((yq & 3) + k) & 3; mc_item<2>(p, lds, (q >> 3) * 32 + (q & 7) * 4 + jcq); } }
                else for (int it = bid; it < 1024; it += G) mc_item<2>(p, lds, (it & ~31) | (((it & 31) + (it >> 8)) & 31));
#if REP_OC > 1
                if (G == 256) { const int xq = bid & 7, yq = bid >> 3;
                    for (int k = 0; k < 4; ++k) { const int q = k * 64 + xq * 8 + (yq >> 2), jcq = ((yq & 3) + k) & 3; mc_item<2>(p, lds, (q >> 3) * 32 + (q & 7) * 4 + jcq); } }
                else for (int it = bid; it < 1024; it += G) mc_item<2>(p, lds, (it & ~31) | (((it & 31) + (it >> 8)) & 31));
#endif
            }
            XSYNC();
            { unsigned char* ws = ows(p); const int KO = l == 0 ? 1024 : 2048; pg8::Gemm g{(const bf16_t*)(ws + WS_Y), (const bf16_t*)(ws + (l == 0 ? WS_WOUTE : WS_WOUTO)), MP, D, KO, KO}; pg8::StaticOrder S; S.init(MP, D, G, bid);
              pg8::EpiB16 E{(bf16_t*)(ws + WS_F)}; pg8::gemm_phase<pg8::EpiB16, pg8::StaticOrder, true, true>(lds, g, S, E); }
            { unsigned char* ws = ows(p); const int KO = l == 0 ? 1024 : 2048; pg8::Gemm g{(const bf16_t*)(ws + WS_Y), (const bf16_t*)(ws + (l == 0 ? WS_WOUTE : WS_WOUTO)), M, D, 256, KO}; pg8::SplitOrder S; S.init(KO / 256, G, bid);
              pg8::EpiPart E{(float*)(ws + WS_PART)}; pg8::gemm_phase<pg8::EpiPart, pg8::SplitOrder, true, true>(lds, g, S, E); }
            XSYNC();
            if (PHMASK & 32768) row_pass(p, 1, 1.0f, p.in[5] + (l * 6 + 3) * D, l == 0 ? 4 : 8);
            XSYNC();
        }
    }
}

extern "C" void kernel_launch(void* const* d_in, const int* in_sizes, int n_in, void* d_out, int out_size, void* d_ws, size_t ws_size, hipStream_t stream) {
    static int grid = 0;
    if (grid == 0) {
        if (n_in != 19 || ws_size < WS_END) { fprintf(stderr, "kernel_launch: unexpected n_in %d / ws %zu (need %zu)\n", n_in, ws_size, (size_t)WS_END); grid = -1; return; }
        int dev = 0, cus = 0, per_cu = 0;
        (void)hipGetDevice(&dev); (void)hipDeviceGetAttribute(&cus, hipDeviceAttributeMultiprocessorCount, dev);
        if (hipFuncSetAttribute((const void*)fwd_megakernel, hipFuncAttributeMaxDynamicSharedMemorySize, LDS_BYTES) != hipSuccess) { fprintf(stderr, "kernel_launch: hipFuncSetAttribute failed\n"); grid = -1; return; }
        if (hipOccupancyMaxActiveBlocksPerMultiprocessor(&per_cu, (const void*)fwd_megakernel, NTHREADS, LDS_BYTES) != hipSuccess || per_cu < 1) { fprintf(stderr, "kernel_launch: occupancy query says %d\n", per_cu); per_cu = 1; }
        (void)hipGetLastError();
        grid = cus * per_cu;
    }
    if (grid < 0) return;
    Params p{};
    for (int i = 0; i < 19; ++i) p.in[i] = (const float*)d_in[i];
    p.out = (float*)d_out; p.ws = (unsigned char*)d_ws;
    if (hipMemsetAsync((char*)d_ws + WS_BAR, 0, 16384, stream) != hipSuccess) { fprintf(stderr, "kernel_launch: memset of barrier words failed\n"); return; }
    void* args[] = {&p};
    hipError_t e = hipLaunchCooperativeKernel((const void*)fwd_megakernel, dim3(grid), dim3(NTHREADS), args, LDS_BYTES, stream);
    if (e != hipSuccess) fprintf(stderr, "cooperative launch failed: %s (grid %d)\n", hipGetErrorString(e), grid);
}
```

```cpp
#include <hip/hip_runtime.h>
#include <hip/hip_cooperative_groups.h>
#include <cstdio>
#include <cstdint>
namespace cg = cooperative_groups;
__device__ __forceinline__ int otid() { int t = threadIdx.x; asm volatile("" : "+v"(t)); return t; }

namespace pg8 {
#define PG8_LAS __attribute__((address_space(3)))
typedef unsigned short bf16_t;
typedef short bf16x8 __attribute__((ext_vector_type(8)));
typedef float f32x4 __attribute__((ext_vector_type(4)));
typedef unsigned u32x4 __attribute__((ext_vector_type(4)));
constexpr int BM = 256, BK = 64, HALF = 128, HTB = HALF * BK * 2  , STAGE_BYTES = 8 * HTB, NXCD = 8, WGM = 8;

__host__ __device__ __forceinline__ int lds_byte(int r, int c) { const int st = (r >> 4) * 2 + (c >> 5), rr = r & 15, cc = c & 31, ob = rr * 64 + cc * 2; return st * 1024 + (ob ^ (((ob >> 9) & 1) << 5)); }
__host__ __device__ __forceinline__ void stage_rc(int b, int& R, int& C) { const int st = b / 1024, sb = b % 1024, swz = sb ^ (((sb >> 9) & 1) << 5); R = (st >> 1) * 16 + swz / 64; C = (st & 1) * 32 + (swz % 64) / 2; }
__host__ __device__ __forceinline__ int perm32(int rho) { const int n = rho >> 4, i = rho & 15; return 8 * (i >> 2) + 4 * n + (i & 3); }

struct Unit { int pm, pn, ks; };
struct Gemm { const bf16_t* A; const bf16_t* Bt; int M, N, K, ld; };

struct StaticOrder {
    int nM, nN, nwg, G, c;
    int rep;
    __host__ __device__ void init(int M, int N, int G_, int c_, int rep_ = 1) { nM = M / BM; nN = N / BM; nwg = nM * nN; G = G_; c = c_; rep = rep_; }
    __host__ __device__ bool next(int i, Unit& u) const {
        long L = (long)i * G + c; if (L >= (long)nwg * rep) return false; if (L >= nwg) L -= nwg;
        int wgid = (int)L; { const int q = nwg / NXCD, r = nwg % NXCD, xcd = wgid % NXCD, off = wgid / NXCD; wgid = (xcd < r ? xcd * (q + 1) : r * (q + 1) + (xcd - r) * q) + off; }
        const int nig = WGM * nN, gid = wgid / nig, fm = gid * WGM, gsz = (nM - fm) < WGM ? (nM - fm) : WGM;
        u.pm = fm + ((wgid % nig) % gsz); u.pn = (wgid % nig) / gsz; u.ks = 0; return true;
    }
    __device__ __forceinline__ void a_ready(const Unit&) const {}
    __device__ __forceinline__ void done(const Unit&) const {}
};

__device__ __forceinline__ unsigned cvt_pk_bf16(float lo, float hi) { unsigned r; asm volatile("v_cvt_pk_bf16_f32 %0, %1, %2" : "=v"(r) : "v"(lo), "v"(hi)); return r; }
__device__ __forceinline__ float silu_f(float x) { return x * __builtin_amdgcn_rcpf(1.0f + __expf(-x)); }
constexpr int MPROMPT = 16384;

struct EpiSwiGLU { static constexpr bool PERM = true, AFTER_DRAIN = false;
    bf16_t* O; const float* rs;
    __device__ __forceinline__ void operator()(const f32x4 (&acc)[2][2][4][2], const Unit& u, int wr, int wc, int fr, int fq) const {
        const int row0 = u.pm * BM + wr * 64 + fr, col0 = u.pn * HALF + wc * 32 + 8 * fq;
#pragma unroll
        for (int ai = 0; ai < 2; ++ai)
#pragma unroll
            for (int m = 0; m < 4; ++m) { const int row = row0 + ai * HALF + m * 16; const float s = rs[row];
                const f32x4 g0 = acc[ai][0][m][0] * s, g1 = acc[ai][0][m][1] * s, u0 = acc[ai][1][m][0] * s, u1 = acc[ai][1][m][1] * s;
                u32x4 w;
                w.x = cvt_pk_bf16(silu_f(g0[0]) * u0[0], silu_f(g0[1]) * u0[1]); w.y = cvt_pk_bf16(silu_f(g0[2]) * u0[2], silu_f(g0[3]) * u0[3]);
                w.z = cvt_pk_bf16(silu_f(g1[0]) * u1[0], silu_f(g1[1]) * u1[1]); w.w = cvt_pk_bf16(silu_f(g1[2]) * u1[2], silu_f(g1[3]) * u1[3]);
                *(u32x4*)(O + (size_t)row * 2816 + col0) = w; }
    }
};
struct EpiF32SS { static constexpr bool PERM = false, AFTER_DRAIN = false;
    float* O; float* ss;
    __device__ __forceinline__ void operator()(const f32x4 (&acc)[2][2][4][2], const Unit& u, int wr, int wc, int fr, int fq) const {
        const int row0 = u.pm * BM + wr * 64 + fr, col0 = u.pn * BM + wc * 32 + 4 * fq;
#pragma unroll
        for (int ai = 0; ai < 2; ++ai)
#pragma unroll
            for (int m = 0; m < 4; ++m) { const int row = row0 + ai * HALF + m * 16; float q = 0.f;
#pragma unroll
                for (int bj = 0; bj < 2; ++bj)
#pragma unroll
                    for (int n = 0; n < 2; ++n) { const f32x4 v = acc[ai][bj][m][n]; *(f32x4*)(O + (size_t)row * 1024 + col0 + bj * HALF + n * 16) = v;
                        q += (v[0] * v[0] + v[1] * v[1]) + (v[2] * v[2] + v[3] * v[3]); }
                q += __shfl_xor(q, 16); q += __shfl_xor(q, 32);
                if (fq == 0) ss[(size_t)row * 16 + u.pn * 4 + wc] = q; }
    }
};
struct SplitOrder {
    int S, nun, G, c;
    __host__ __device__ void init(int S_, int G_, int c_) { S = S_; nun = 16 * S_; G = G_; c = c_; }
    __host__ __device__ bool next(int i, Unit& u) const { const int L = i * G + c; if (L >= nun) return false; const int tile = L / S; u.ks = L - tile * S; u.pm = 64 + (tile >> 2); u.pn = tile & 3; return true; }
    __device__ __forceinline__ void a_ready(const Unit&) const {}
    __device__ __forceinline__ void done(const Unit&) const {}
};
struct EpiF32 { static constexpr bool PERM = false, AFTER_DRAIN = false;
    float* O;
    __device__ __forceinline__ void operator()(const f32x4 (&acc)[2][2][4][2], const Unit& u, int wr, int wc, int fr, int fq) const {
        const int row0 = u.pm * BM + wr * 64 + fr, col0 = u.pn * BM + wc * 32 + 4 * fq;
#pragma unroll
        for (int ai = 0; ai < 2; ++ai)
#pragma unroll
            for (int m = 0; m < 4; ++m) { const int row = row0 + ai * HALF + m * 16;
#pragma unroll
                for (int bj = 0; bj < 2; ++bj)
#pragma unroll
                    for (int n = 0; n < 2; ++n) *(f32x4*)(O + (size_t)row * 1024 + col0 + bj * HALF + n * 16) = acc[ai][bj][m][n]; }
    }
};
struct EpiB16 { static constexpr bool PERM = true, AFTER_DRAIN = false;
    bf16_t* O;
    __device__ __forceinline__ void operator()(const f32x4 (&acc)[2][2][4][2], const Unit& u, int wr, int wc, int fr, int fq) const {
        const int row0 = u.pm * BM + wr * 64 + fr, col0 = u.pn * BM + wc * 32 + 8 * fq;
#pragma unroll
        for (int ai = 0; ai < 2; ++ai)
#pragma unroll
            for (int m = 0; m < 4; ++m) { const int row = row0 + ai * HALF + m * 16;
#pragma unroll
                for (int bj = 0; bj < 2; ++bj) { const f32x4 v0 = acc[ai][bj][m][0], v1 = acc[ai][bj][m][1]; u32x4 w;
                    w.x = cvt_pk_bf16(v0[0], v0[1]); w.y = cvt_pk_bf16(v0[2], v0[3]); w.z = cvt_pk_bf16(v1[0], v1[1]); w.w = cvt_pk_bf16(v1[2], v1[3]);
                    *(u32x4*)(O + (size_t)row * 1024 + col0 + bj * HALF) = w; } }
    }
};
struct EpiPart { static constexpr bool PERM = false, AFTER_DRAIN = false;
    float* O;
    __device__ __forceinline__ void operator()(const f32x4 (&acc)[2][2][4][2], const Unit& u, int wr, int wc, int fr, int fq) const {
        const int row0 = (u.pm - 64) * BM + wr * 64 + fr, col0 = u.pn * BM + wc * 32 + 4 * fq;
        float* Ob = O + (size_t)u.ks * 1024 * 1024;
#pragma unroll
        for (int ai = 0; ai < 2; ++ai)
#pragma unroll
            for (int m = 0; m < 4; ++m) { const int row = row0 + ai * HALF + m * 16;
#pragma unroll
                for (int bj = 0; bj < 2; ++bj)
#pragma unroll
                    for (int n = 0; n < 2; ++n) *(f32x4*)(Ob + (size_t)row * 1024 + col0 + bj * HALF + n * 16) = acc[ai][bj][m][n]; }
    }
};
struct EpiScale { static constexpr bool PERM = true, AFTER_DRAIN = false;
    bf16_t* O; int ldc; const float* rs;
    __device__ __forceinline__ void operator()(const f32x4 (&acc)[2][2][4][2], const Unit& u, int wr, int wc, int fr, int fq) const {
        const int row0 = u.pm * BM + wr * 64 + fr, col0 = u.pn * BM + wc * 32 + 8 * fq;
#pragma unroll
        for (int ai = 0; ai < 2; ++ai)
#pragma unroll
            for (int m = 0; m < 4; ++m) { const int row = row0 + ai * HALF + m * 16; const float s = rs[row];
#pragma unroll
                for (int bj = 0; bj < 2; ++bj) { const f32x4 v0 = acc[ai][bj][m][0] * s, v1 = acc[ai][bj][m][1] * s; u32x4 w;
                    w.x = cvt_pk_bf16(v0[0], v0[1]); w.y = cvt_pk_bf16(v0[2], v0[3]); w.z = cvt_pk_bf16(v1[0], v1[1]); w.w = cvt_pk_bf16(v1[2], v1[3]);
                    *(u32x4*)(O + (size_t)row * ldc + col0 + bj * HALF) = w; } }
    }
};
struct EpiRet { static constexpr bool PERM = true, AFTER_DRAIN = false;
    bf16_t* O; const float* rs; const float* cosT; const float* sinT;
    __device__ __forceinline__ void operator()(const f32x4 (&acc)[2][2][4][2], const Unit& u, int wr, int wc, int fr, int fq) const {
        const int row0 = u.pm * BM + wr * 64 + fr, col0 = u.pn * BM + wc * 32 + 8 * fq;
        const bool rot = u.pn < 8; const int hh = u.pn & 3; const bool isk = u.pn >= 4;
        const float l2g = __log2f(1.0f - exp2f(-5.0f - (float)hh));
#pragma unroll
        for (int ai = 0; ai < 2; ++ai)
#pragma unroll
            for (int m = 0; m < 4; ++m) { const int row = row0 + ai * HALF + m * 16; float s = rs[row];
                if (!rot) {
#pragma unroll
                    for (int bj = 0; bj < 2; ++bj) { const f32x4 v0 = acc[ai][bj][m][0] * s, v1 = acc[ai][bj][m][1] * s; u32x4 w;
                        w.x = cvt_pk_bf16(v0[0], v0[1]); w.y = cvt_pk_bf16(v0[2], v0[3]); w.z = cvt_pk_bf16(v1[0], v1[1]); w.w = cvt_pk_bf16(v1[2], v1[3]);
                        *(u32x4*)(O + (size_t)row * 6144 + col0 + bj * HALF) = w; }
                } else {
                    int pi; float sc;
                    if (row < MPROMPT) { const int pos = row & 2047, tau = pos & 255; pi = pos;
                        sc = isk ? exp2f((float)(128 - tau) * l2g) * 0.0625f : exp2f((float)(tau - 128) * l2g); }
                    else { pi = 2048 + (row & 7); sc = isk ? 0.0625f : 1.0f; }
                    s *= sc;
                    const int fi = wc * 32 + 8 * fq;
                    const f32x4 c0 = *(const f32x4*)(cosT + pi * 128 + fi), c1 = *(const f32x4*)(cosT + pi * 128 + fi + 4);
                    const f32x4 s0 = *(const f32x4*)(sinT + pi * 128 + fi), s1 = *(const f32x4*)(sinT + pi * 128 + fi + 4);
                    const f32x4 a0 = acc[ai][0][m][0] * s, a1 = acc[ai][0][m][1] * s, b0 = acc[ai][1][m][0] * s, b1 = acc[ai][1][m][1] * s;
                    const f32x4 p0 = a0 * c0 - b0 * s0, p1 = a1 * c1 - b1 * s1, q0 = a0 * s0 + b0 * c0, q1 = a1 * s1 + b1 * c1;
                    u32x4 w;
                    w.x = cvt_pk_bf16(p0[0], p0[1]); w.y = cvt_pk_bf16(p0[2], p0[3]); w.z = cvt_pk_bf16(p1[0], p1[1]); w.w = cvt_pk_bf16(p1[2], p1[3]);
                    *(u32x4*)(O + (size_t)row * 6144 + col0) = w;
                    w.x = cvt_pk_bf16(q0[0], q0[1]); w.y = cvt_pk_bf16(q0[2], q0[3]); w.z = cvt_pk_bf16(q1[0], q1[1]); w.w = cvt_pk_bf16(q1[2], q1[3]);
                    *(u32x4*)(O + (size_t)row * 6144 + col0 + HALF) = w;
                } }
    }
};

template <class Epi, class Sched, bool ALIGN_EPI = false, bool SP2 = false>
__device__ __forceinline__ void gemm_phase(PG8_LAS unsigned char* lds, const Gemm g, const Sched& S, const Epi& E) {
    const int tid = otid(), wid = __builtin_amdgcn_readfirstlane(tid >> 6), lane = tid & 63, wr = wid >> 2, wc = wid & 3, fr = lane & 15, fq = lane >> 4;
    const int K = g.K, nt = K / BK;
    unsigned voffA[2], voffB[2];
#pragma unroll
    for (int i = 0; i < 2; ++i) { int R, C; stage_rc(tid * 16 + i * 8192, R, C); const int Rb = Epi::PERM ? ((R & ~31) + perm32(R & 31)) : R;
        voffA[i] = (unsigned)(R * g.ld + C) * 2u; voffB[i] = (unsigned)(Rb * g.ld + C) * 2u; }
    const size_t kstep = (size_t)(BK * 2);
    const size_t hstep = (size_t)HALF * g.ld * 2;
    const size_t tstep = 2 * hstep;
    const unsigned ldsw = (unsigned)wid * 1024u;
    const int aoff = lds_byte(wr * 64 + fr, fq * 8), boff = lds_byte(wc * 32 + fr, fq * 8);
#define PG8_SA(b, h) (((b) * 2 + (h)) * HTB)
#define PG8_SB(b, h) ((4 + (b) * 2 + (h)) * HTB)
#define PG8_STAGE(bufoff, gbase, voff) do { _Pragma("unroll") for (int _i = 0; _i < 2; ++_i) \
        __builtin_amdgcn_global_load_lds((const unsigned*)((const char*)(gbase) + (voff)[_i]), (PG8_LAS unsigned*)(lds + (bufoff) + ldsw + _i * 8192), 16, 0, 0); } while (0)
#define PG8_LDA(dst, b, h) do { _Pragma("unroll") for (int m = 0; m < 4; ++m) _Pragma("unroll") for (int k = 0; k < 2; ++k) dst[m][k] = *(const PG8_LAS bf16x8*)(lds + PG8_SA(b, h) + aoff + m * 2048 + k * 1024); } while (0)
#define PG8_LDB(dst, b, h) do { _Pragma("unroll") for (int n = 0; n < 2; ++n) _Pragma("unroll") for (int k = 0; k < 2; ++k) dst[n][k] = *(const PG8_LAS bf16x8*)(lds + PG8_SB(b, h) + boff + n * 2048 + k * 1024); } while (0)
#define PG8_MMA(ai, bj, At, Bt) do { __builtin_amdgcn_s_setprio(1); _Pragma("unroll") for (int m = 0; m < 4; ++m) _Pragma("unroll") for (int n = 0; n < 2; ++n) _Pragma("unroll") for (int k = 0; k < 2; ++k) \
        acc[ai][bj][m][n] = __builtin_amdgcn_mfma_f32_16x16x32_bf16(Bt[n][k], At[m][k], acc[ai][bj][m][n], 0, 0, 0); __builtin_amdgcn_s_setprio(0); } while (0)
#define PG8_WAIT_V(n) asm volatile("s_waitcnt vmcnt(" #n ")" ::: "memory")
#define PG8_WAIT_L(n) asm volatile("s_waitcnt lgkmcnt(" #n ")" ::: "memory")
#define PG8_BAR __builtin_amdgcn_s_barrier()
#define PG8_SCHED __builtin_amdgcn_sched_barrier(0)
    Unit cur, nxt; int ui = 0;
    if (!S.next(0, cur)) return;
    f32x4 acc[2][2][4][2];
#pragma unroll
    for (int a = 0; a < 2; ++a)
#pragma unroll
        for (int b = 0; b < 2; ++b)
#pragma unroll
            for (int m = 0; m < 4; ++m)
#pragma unroll
                for (int n = 0; n < 2; ++n) acc[a][b][m][n] = (f32x4){0.f, 0.f, 0.f, 0.f};
    bf16x8 At[4][2], B0[2][2], B1[2][2];
    const char* cA = (const char*)g.A + (size_t)cur.pm * tstep + (size_t)cur.ks * K * 2; const char* cB = (const char*)g.Bt + (size_t)cur.pn * tstep + (size_t)cur.ks * K * 2;
    S.a_ready(cur);
    if constexpr (SP2) {
        PG8_STAGE(PG8_SB(0, 0), cB, voffB); PG8_STAGE(PG8_SB(0, 1), cB + hstep, voffB); PG8_STAGE(PG8_SA(0, 0), cA, voffA); PG8_STAGE(PG8_SA(0, 1), cA + hstep, voffA);
        if (wr == 1) PG8_BAR;
        PG8_WAIT_V(2); PG8_BAR;
        PG8_STAGE(PG8_SB(1, 0), cB + kstep, voffB); PG8_STAGE(PG8_SA(1, 0), cA + kstep, voffA); PG8_STAGE(PG8_SB(1, 1), cB + hstep + kstep, voffB);
        PG8_WAIT_V(6); PG8_BAR;
    } else {
        PG8_STAGE(PG8_SB(0, 0), cB, voffB); PG8_STAGE(PG8_SA(0, 0), cA, voffA); PG8_STAGE(PG8_SB(0, 1), cB + hstep, voffB); PG8_STAGE(PG8_SA(0, 1), cA + hstep, voffA);
        if (wr == 1) PG8_BAR;
        PG8_WAIT_V(4); PG8_BAR;
        PG8_STAGE(PG8_SB(1, 0), cB + kstep, voffB); PG8_STAGE(PG8_SA(1, 0), cA + kstep, voffA); PG8_STAGE(PG8_SB(1, 1), cB + hstep + kstep, voffB);
        PG8_WAIT_V(6); PG8_BAR;
    }
    for (;;) {
        const bool has_next = S.next(ui + 1, nxt);
        const char* nA = has_next ? (const char*)g.A + (size_t)nxt.pm * tstep + (size_t)nxt.ks * K * 2 : cA; const char* nB = has_next ? (const char*)g.Bt + (size_t)nxt.pn * tstep + (size_t)nxt.ks * K * 2 : cB;
        for (int t = 0; t < nt; t += 2) {
            const bool last = (t == nt - 2);
            const char* a1 = cA + (size_t)(t + 1) * kstep;
            const char* a2 = last ? nA : cA + (size_t)(t + 2) * kstep; const char* b2 = last ? nB : cB + (size_t)(t + 2) * kstep;
            const char* a3 = a2 + kstep; const char* b3 = b2 + kstep;
            if (last && has_next) S.a_ready(nxt);
            if constexpr (SP2) {
            PG8_LDB(B0, 0, 0); PG8_LDB(B1, 0, 1); PG8_SCHED; PG8_LDA(At, 0, 0); PG8_STAGE(PG8_SA(1, 1), a1 + hstep, voffA);
            PG8_WAIT_V(8); PG8_WAIT_L(0); PG8_BAR; PG8_MMA(0, 0, At, B0); PG8_MMA(0, 1, At, B1); PG8_BAR; PG8_SCHED;
            PG8_LDA(At, 0, 1); PG8_STAGE(PG8_SB(0, 0), b2, voffB); PG8_STAGE(PG8_SB(0, 1), b2 + hstep, voffB); PG8_STAGE(PG8_SA(0, 0), a2, voffA);
            PG8_WAIT_V(8); PG8_WAIT_L(0); PG8_BAR; PG8_MMA(1, 0, At, B0); PG8_MMA(1, 1, At, B1); PG8_BAR; PG8_SCHED;
            PG8_LDB(B0, 1, 0); PG8_LDB(B1, 1, 1); PG8_SCHED; PG8_LDA(At, 1, 0); PG8_STAGE(PG8_SA(0, 1), a2 + hstep, voffA);
            PG8_WAIT_V(8); PG8_WAIT_L(0); PG8_BAR; PG8_MMA(0, 0, At, B0); PG8_MMA(0, 1, At, B1); PG8_BAR; PG8_SCHED;
            PG8_LDA(At, 1, 1); PG8_STAGE(PG8_SB(1, 0), b3, voffB); PG8_STAGE(PG8_SB(1, 1), b3 + hstep, voffB); PG8_STAGE(PG8_SA(1, 0), a3, voffA);
            PG8_WAIT_V(8); PG8_WAIT_L(0); PG8_BAR; PG8_MMA(1, 0, At, B0); PG8_MMA(1, 1, At, B1); PG8_BAR; PG8_SCHED;
            } else {
            PG8_LDB(B0, 0, 0); PG8_SCHED; PG8_LDA(At, 0, 0); PG8_STAGE(PG8_SA(1, 1), a1 + hstep, voffA);
            PG8_WAIT_L(8); PG8_BAR; PG8_WAIT_L(0); PG8_MMA(0, 0, At, B0); PG8_BAR; PG8_SCHED;
            PG8_LDB(B1, 0, 1); PG8_STAGE(PG8_SB(0, 0), b2, voffB);
            PG8_BAR; PG8_WAIT_L(0); PG8_MMA(0, 1, At, B1); PG8_BAR;
            PG8_LDA(At, 0, 1); PG8_STAGE(PG8_SA(0, 0), a2, voffA);
            PG8_BAR; PG8_WAIT_L(0); PG8_MMA(1, 0, At, B0); PG8_BAR; PG8_SCHED;
            PG8_STAGE(PG8_SB(0, 1), b2 + hstep, voffB);
            PG8_WAIT_V(6); PG8_BAR; PG8_MMA(1, 1, At, B1); PG8_BAR;
            PG8_LDB(B0, 1, 0); PG8_SCHED; PG8_LDA(At, 1, 0); PG8_STAGE(PG8_SA(0, 1), a2 + hstep, voffA);
            PG8_WAIT_L(8); PG8_BAR; PG8_WAIT_L(0); PG8_MMA(0, 0, At, B0); PG8_BAR; PG8_SCHED;
            PG8_LDB(B1, 1, 1); PG8_STAGE(PG8_SB(1, 0), b3, voffB);
            PG8_BAR; PG8_WAIT_L(0); PG8_MMA(0, 1, At, B1); PG8_BAR;
            PG8_LDA(At, 1, 1); PG8_STAGE(PG8_SA(1, 0), a3, voffA);
            PG8_BAR; PG8_WAIT_L(0); PG8_MMA(1, 0, At, B0); PG8_BAR; PG8_SCHED;
            PG8_STAGE(PG8_SB(1, 1), b3 + hstep, voffB);
            PG8_WAIT_V(6); PG8_BAR; PG8_MMA(1, 1, At, B1); PG8_BAR;
            }
        }
        if constexpr (ALIGN_EPI) { if (wr == 0) PG8_BAR; }
        if constexpr (!Epi::AFTER_DRAIN) { E(acc, cur, wr, wc, fr, fq); S.done(cur); }
        if (!has_next) break;
#pragma unroll
        for (int a = 0; a < 2; ++a)
#pragma unroll
            for (int b = 0; b < 2; ++b)
#pragma unroll
                for (int m = 0; m < 4; ++m)
#pragma unroll
                    for (int n = 0; n < 2; ++n) acc[a][b][m][n] = (f32x4){0.f, 0.f, 0.f, 0.f};
        cur = nxt; cA = nA; cB = nB; ++ui;
        if constexpr (ALIGN_EPI) { if (wr == 1) PG8_BAR; }
    }
    PG8_WAIT_V(0);
    if constexpr (!ALIGN_EPI) { if (wr == 0) PG8_BAR; }
    PG8_BAR;
    if constexpr (Epi::AFTER_DRAIN) { E.fused(acc, cur, wr, wc, fr, fq, lds, wid, lane); S.done(cur); }
#undef PG8_SA
#undef PG8_SB
#undef PG8_STAGE
#undef PG8_LDA
#undef PG8_LDB
#undef PG8_MMA
#undef PG8_WAIT_V
#undef PG8_WAIT_L
#undef PG8_BAR
#undef PG8_SCHED
}
}

#define LAS __attribute__((address_space(3)))
typedef unsigned short bf16_t;
typedef short bf16x8 __attribute__((ext_vector_type(8)));
typedef float f32x4 __attribute__((ext_vector_type(4)));
typedef unsigned u32x4 __attribute__((ext_vector_type(4)));
typedef unsigned u32x2 __attribute__((ext_vector_type(2)));
typedef LAS unsigned char* ldsp;

constexpr int D = 1024, FF = 2816, MP = 16384, MS = 1024, M = MP + MS, NUP = 2 * FF, NE = 3840, NO = 6144;
constexpr float EPS = 1e-6f;
constexpr int E_QA = 0, E_KA = 256, E_VA = 512, E_RA = 1024, E_QB = 1536, E_FB = 2048, E_IB = 2560, E_GB = 3072, E_LR = 3584;
constexpr int O_Q = 0, O_K = 1024, O_V = 2048, O_G = 4096;
constexpr int NTHREADS = 512;
constexpr int LDS_BYTES = 155648;
#ifndef TREP_UP
#define TREP_UP 1
#endif
#ifndef TREP_IN
#define TREP_IN 1
#endif
#ifndef TREP_DN
#define TREP_DN 1
#endif
#ifndef REP_P0
#define REP_P0 1
#endif
#ifndef REP_ME
#define REP_ME 1
#endif
#ifndef REP_MO
#define REP_MO 1
#endif
#ifndef REP_OA
#define REP_OA 1
#endif
#ifndef REP_OB
#define REP_OB 1
#endif
#ifndef REP_OS
#define REP_OS 1
#endif
#ifndef REP_OC
#define REP_OC 1
#endif
#ifndef REP_UP
#define REP_UP 1
#endif
#ifndef REP_G
#define REP_G 1
#endif
#ifndef REP_M
#define REP_M 1
#endif
#ifndef EXTRA_SYNCS
#define EXTRA_SYNCS 0
#endif
#ifndef STOPAT
#define STOPAT 1000
#endif
#ifndef PHMASK
#define PHMASK 0xFFFF
#define DBGSKIP 0
#define NANFIX2 1
#endif

constexpr size_t al256(size_t x) { return (x + 255) & ~(size_t)255; }
constexpr size_t SZ_WUP = (size_t)NUP * D * 2, SZ_WDN = (size_t)D * FF * 2;
constexpr size_t WS_WUP = 0;
constexpr size_t WS_WDN = WS_WUP + 4 * SZ_WUP;
constexpr size_t WS_WINE = WS_WDN + 4 * SZ_WDN;
constexpr size_t WS_WOUTE = WS_WINE + (size_t)NE * D * 2;
constexpr size_t WS_WINO = WS_WOUTE + (size_t)D * D * 2;
constexpr size_t WS_WOUTO = WS_WINO + (size_t)NO * D * 2;
constexpr size_t WS_XB = WS_WOUTO + (size_t)D * 2048 * 2;
constexpr size_t WS_RS = WS_XB + (size_t)M * D * 2;
constexpr size_t WS_SS = WS_RS + al256((size_t)M * 4);
constexpr size_t WS_ACT = WS_SS + al256((size_t)M * 16 * 4);
constexpr size_t WS_F = WS_ACT + (size_t)M * FF * 2;
constexpr size_t WS_P = WS_F + (size_t)M * D * 4;
constexpr size_t WS_Y = WS_P + (size_t)M * NO * 2;
constexpr size_t WS_QT = WS_Y + (size_t)M * 2048 * 2;
constexpr size_t WS_QH = WS_QT + (size_t)MP * 768 * 2;
constexpr size_t WS_KT = WS_QH + (size_t)MP * 768 * 2;
constexpr size_t WS_HL = WS_KT + (size_t)MP * 768 * 2;
constexpr size_t HL_HGRN = (size_t)1024 * 128 * 64 * 4;
constexpr size_t WS_DEC = WS_HL + (size_t)134217728;
constexpr size_t DEC_HGRN = (size_t)1024 * 64 * 4;
constexpr size_t WS_ST = WS_DEC + (size_t)1048576;
constexpr size_t ST_HGRN = (size_t)1024 * 128 * 64 * 2;
constexpr size_t WS_COS = WS_ST + (size_t)67108864;
constexpr size_t WS_SIN = WS_COS + al256((size_t)2056 * 128 * 4);
constexpr size_t WS_BAR = WS_SIN + al256((size_t)2056 * 128 * 4);
constexpr size_t WS_PART = WS_BAR + 16384;
constexpr size_t WS_END = WS_PART + (size_t)11 * 1024 * 1024 * 4;

constexpr size_t OUT_GLA_P = 17825792, OUT_HGRN_P = 18087936, OUT_RET_P = 18612224, OUT_GLA_S = 22806528, OUT_HGRN_S = 27000832, OUT_RET_S = 35389440;

struct Params { const float* in[19]; float* out; unsigned char* ws; };

__device__ __forceinline__ unsigned f2bf(float f) { unsigned u = __builtin_bit_cast(unsigned, f); return (u + 0x7fffu + ((u >> 16) & 1u)) >> 16; }
__device__ __forceinline__ float bf2f(unsigned u) { return __builtin_bit_cast(float, u << 16); }
__device__ __forceinline__ unsigned pk2(float lo, float hi) { return pg8::cvt_pk_bf16(lo, hi); }
__device__ __forceinline__ float siluf(float x) { return x * __builtin_amdgcn_rcpf(1.0f + __expf(-x)); }
__device__ __forceinline__ float wave_sum(float v) {
#pragma unroll
    for (int o = 1; o < 64; o <<= 1) v += __shfl_xor(v, o);
    return v;
}
__device__ __forceinline__ f32x4 mma16(bf16x8 a, bf16x8 b, f32x4 c) { return __builtin_amdgcn_mfma_f32_16x16x32_bf16(a, b, c, 0, 0, 0); }
__device__ __forceinline__ bf16x8 ldfrag(ldsp base, int elem) { return *(const LAS bf16x8*)(base + (size_t)elem * 2); }
__device__ __forceinline__ float logsig(float x) { return fminf(x, 0.f) - __logf(1.0f + __expf(-fabsf(x))); }

template <int F> __device__ __forceinline__ void stage_rows(ldsp dst, int dp, const bf16_t* src, size_t sp, int tid) {
    constexpr int G8 = F / 8;
#pragma unroll
    for (int it = 0; it < (64 * G8) / NTHREADS; ++it) { const int idx = tid + it * NTHREADS; const int s = idx / G8, g = idx % G8;
        const u32x4 w = *(const u32x4*)(src + (size_t)s * sp + g * 8);
        *(LAS u32x4*)(dst + (size_t)(s * dp + g * 8) * 2) = w; }
}
template <int F> __device__ __forceinline__ void stage_T(ldsp dst, int dp_unused, const bf16_t* src, size_t sp, int wave, int lane) {
    const bf16_t* gb = src + (size_t)(32 * (wave & 1) + (lane & 31)) * sp + (2 * (wave >> 1) + (lane >> 5)) * 8;
    ldsp base = dst + (size_t)((2 * (wave >> 1) + (lane >> 5)) * 8 * 72 + 32 * (wave & 1) + (lane & 31)) * 2;
    constexpr int UF = (F / 64 > 2) ? 2 : F / 64;
#pragma unroll UF
    for (int it = 0; it < F / 64; ++it) { const u32x4 w = *(const u32x4*)(gb + 64 * it);
#pragma unroll
        for (int i = 0; i < 4; ++i) {
            *(LAS bf16_t*)(base + (64 * it + 2 * i) * 144) = (bf16_t)(w[i] & 0xffffu);
            *(LAS bf16_t*)(base + (64 * it + 2 * i + 1) * 144) = (bf16_t)(w[i] >> 16); } }
}

template <int F> __device__ __forceinline__ void ld_rows(u32x4 (&r)[(64 * (F / 8)) / NTHREADS], const bf16_t* src, size_t sp, int tid) {
    constexpr int G8 = F / 8;
#pragma unroll
    for (int it = 0; it < (64 * G8) / NTHREADS; ++it) { const int idx = tid + it * NTHREADS; const int s = idx / G8, g = idx % G8; r[it] = *(const u32x4*)(src + (size_t)s * sp + g * 8); }
}
template <int F> __device__ __forceinline__ void st_rows(ldsp dst, int dp, const u32x4 (&r)[(64 * (F / 8)) / NTHREADS], int tid) {
    constexpr int G8 = F / 8;
#pragma unroll
    for (int it = 0; it < (64 * G8) / NTHREADS; ++it) { const int idx = tid + it * NTHREADS; const int s = idx / G8, g = idx % G8; *(LAS u32x4*)(dst + (size_t)(s * dp + g * 8) * 2) = r[it]; }
}
template <int F> __device__ __forceinline__ void ld_T(u32x4 (&r)[F / 64], const bf16_t* src, size_t sp, int wave, int lane) {
    const bf16_t* base = src + (size_t)(32 * (wave & 1) + (lane & 31)) * sp + (2 * (wave >> 1) + (lane >> 5)) * 8;
#pragma unroll
    for (int it = 0; it < F / 64; ++it) r[it] = *(const u32x4*)(base + 64 * it);
}
template <int F> __device__ __forceinline__ void st_T(ldsp dst, int dp_unused, const u32x4 (&r)[F / 64], int wave, int lane) {
    ldsp base = dst + (size_t)((2 * (wave >> 1) + (lane >> 5)) * 8 * 72 + 32 * (wave & 1) + (lane & 31)) * 2;
#pragma unroll
    for (int it = 0; it < F / 64; ++it) { const u32x4 w = r[it];
#pragma unroll
        for (int i = 0; i < 4; ++i) {
            *(LAS bf16_t*)(base + (64 * it + 2 * i) * 144) = (bf16_t)(w[i] & 0xffffu);
            *(LAS bf16_t*)(base + (64 * it + 2 * i + 1) * 144) = (bf16_t)(w[i] >> 16); } }
}
__device__ __forceinline__ void row_pass(const Params& p, int mode, float coef, const float* nw, int nsplit) {
    const int tid = otid(), lane = tid & 63, wave = tid >> 6;
    const int gw = blockIdx.x * 8 + wave, NGW = gridDim.x * 8;
    float* RS = (float*)(p.ws + WS_RS); const bf16_t* Fb = (const bf16_t*)(p.ws + WS_F); bf16_t* XB = (bf16_t*)(p.ws + WS_XB);
    const bool xcd_map = gridDim.x == 256; const int wx = (blockIdx.x >> 3) * 8 + wave;
    for (int it = 0; it < (xcd_map ? 9 : (M + NGW - 1) / NGW); ++it) {
        int r;
        if (xcd_map) { if (it < 8) r = 2048 * (blockIdx.x & 7) + wx + 256 * it; else { r = MP + gw; if (gw >= MS) break; } }
        else { r = gw + it * NGW; if (r >= M) break; }
        u32x2* B2 = (u32x2*)(XB + (size_t)r * D);
        f32x4 v[4];
        if (mode == 0) { const f32x4* s4 = (r < MP) ? (const f32x4*)(p.in[0] + (size_t)r * D) : (const f32x4*)(p.in[1] + (size_t)(r - MP) * D);
#pragma unroll
            for (int j = 0; j < 4; ++j) v[j] = __builtin_nontemporal_load(s4 + 64 * j + lane);
        } else { f32x4 fv[4]; u32x2 xw[4];
#pragma unroll
            for (int j = 0; j < 4; ++j) xw[j] = B2[64 * j + lane];
            if (r < MP) { const u32x2* F2 = (const u32x2*)(Fb + (size_t)r * D);
#pragma unroll
                for (int j = 0; j < 4; ++j) { const u32x2 w = __builtin_nontemporal_load(F2 + 64 * j + lane); fv[j] = (f32x4){bf2f(w.x & 0xffffu), bf2f(w.x >> 16), bf2f(w.y & 0xffffu), bf2f(w.y >> 16)}; }
            } else { const f32x4* P4 = (const f32x4*)(p.ws + WS_PART) + (size_t)(r - MP) * 256;
#pragma unroll
                for (int j = 0; j < 4; ++j) fv[j] = (f32x4){0.f, 0.f, 0.f, 0.f};
                for (int ks = 0; ks < nsplit; ++ks) {
#pragma unroll
                    for (int j = 0; j < 4; ++j) fv[j] += __builtin_nontemporal_load(P4 + (size_t)ks * 262144 + 64 * j + lane); } }
            float q = 0.f;
#pragma unroll
            for (int j = 0; j < 4; ++j) q += (fv[j][0] * fv[j][0] + fv[j][1] * fv[j][1]) + (fv[j][2] * fv[j][2] + fv[j][3] * fv[j][3]);
            q = wave_sum(q);
            const float rstd = rsqrtf(q * (1.0f / D) + EPS) * coef; const f32x4* W4 = (const f32x4*)nw;
#pragma unroll
            for (int j = 0; j < 4; ++j) { const f32x4 xv = (f32x4){bf2f(xw[j].x & 0xffffu), bf2f(xw[j].x >> 16), bf2f(xw[j].y & 0xffffu), bf2f(xw[j].y >> 16)};
                v[j] = xv + fv[j] * W4[64 * j + lane] * rstd; }
        }
        if (mode == 2) { f32x4* X4 = (f32x4*)(p.out + (size_t)r * D);
#pragma unroll
            for (int j = 0; j < 4; ++j) X4[64 * j + lane] = v[j];
        } else {
            float s = 0.f;
#pragma unroll
            for (int j = 0; j < 4; ++j) s += (v[j][0] * v[j][0] + v[j][1] * v[j][1]) + (v[j][2] * v[j][2] + v[j][3] * v[j][3]);
            s = wave_sum(s);
#pragma unroll
            for (int j = 0; j < 4; ++j) { u32x2 w; w.x = pk2(v[j][0], v[j][1]); w.y = pk2(v[j][2], v[j][3]); B2[64 * j + lane] = w; }
            if (lane == 0) RS[r] = rsqrtf(s * (1.0f / D) + EPS);
        }
    }
}

__device__ __forceinline__ int dst_row(int n, int mode) {
    if (mode == 1) return ((n >> 7) << 8) + (n & 127);
    if (mode == 2) return ((n >> 7) << 8) + 128 + (n & 127);
    if (mode == 3) return n < 1536 ? n : (n < 1552 ? n + 2048 : n - 16);
    return n;
}
__device__ __forceinline__ void transpose_item(const float* W, int K, int N, bf16_t* WT, int mode, const float* ksc, LAS float* scr, int item, int lane) {
    const int nblk = (N + 31) / 32, kb = item / nblk, nb = item % nblk, k0 = 64 * kb, n0 = 32 * nb;
    const int nn = n0 + (lane & 31);
    float tv[32];
#pragma unroll
    for (int i = 0; i < 32; ++i) { const int kk = 2 * i + (lane >> 5); tv[i] = (nn < N) ? __builtin_nontemporal_load(W + (size_t)(k0 + kk) * N + nn) : 0.f; }
#pragma unroll
    for (int i = 0; i < 32; ++i) { const int kk = 2 * i + (lane >> 5); float v = tv[i]; if (ksc) v *= ksc[k0 + kk]; scr[kk * 33 + (lane & 31)] = v; }
    asm volatile("s_waitcnt lgkmcnt(0)" ::: "memory");
    const int c = lane & 7;
#pragma unroll
    for (int j = 0; j < 4; ++j) { const int nl = (lane >> 3) + 8 * j; const LAS float* s = scr + (8 * c) * 33 + nl;
        u32x4 o; o.x = pk2(s[0 * 33], s[1 * 33]); o.y = pk2(s[2 * 33], s[3 * 33]); o.z = pk2(s[4 * 33], s[5 * 33]); o.w = pk2(s[6 * 33], s[7 * 33]);
        if (n0 + nl < N) *(u32x4*)(WT + (size_t)dst_row(n0 + nl, mode) * K + k0 + 8 * c) = o; }
    asm volatile("s_waitcnt lgkmcnt(0)" ::: "memory");
}
__device__ __forceinline__ void prologue(const Params& p, ldsp lds) {
    const int tid = otid(), lane = tid & 63, wave = tid >> 6;
    LAS float* scr = (LAS float*)(lds + wave * 16384);
    const int gw = blockIdx.x * 8 + wave, NGW = gridDim.x * 8;
    const float* nw = p.in[5];
    constexpr int I_UP = 16 * 88, I_DN = 44 * 32, I_EI = 16 * 113, I_EO = 16 * 32, I_OI = 16 * 192, I_OO = 32 * 32;
    constexpr int NITEMS = 8 * I_UP + 4 * I_DN + I_EI + I_EO + I_OI + I_OO;
    for (int it = gw; it < NITEMS; it += NGW) {
        int r = it;
        if (r < 8 * I_UP) { const int f = r / (2 * I_UP), rr = r % (2 * I_UP), isup = rr >= I_UP, ii = rr % I_UP; const int l = f >> 1, j = f & 1;
            transpose_item((isup ? p.in[7] : p.in[6]) + (size_t)f * D * FF, D, FF, (bf16_t*)(p.ws + WS_WUP + f * SZ_WUP), isup ? 2 : 1, nw + (l * 6 + (j ? 4 : 0)) * D, scr, ii, lane); continue; }
        r -= 8 * I_UP;
        if (r < 4 * I_DN) { const int f = r / I_DN, ii = r % I_DN;
            transpose_item(p.in[8] + (size_t)f * FF * D, FF, D, (bf16_t*)(p.ws + WS_WDN + f * SZ_WDN), 0, nullptr, scr, ii, lane); continue; }
        r -= 4 * I_DN;
        if (r < I_EI) { transpose_item(p.in[9], D, 3600, (bf16_t*)(p.ws + WS_WINE), 3, nw + 2 * D, scr, r, lane); continue; }
        r -= I_EI;
        if (r < I_EO) { transpose_item(p.in[15], D, D, (bf16_t*)(p.ws + WS_WOUTE), 0, nullptr, scr, r, lane); continue; }
        r -= I_EO;
        if (r < I_OI) { transpose_item(p.in[16], D, NO, (bf16_t*)(p.ws + WS_WINO), 0, nw + 8 * D, scr, r, lane); continue; }
        r -= I_OI;
        transpose_item(p.in[18], 2048, D, (bf16_t*)(p.ws + WS_WOUTO), 0, nullptr, scr, r, lane);
    }
    const int gtid = blockIdx.x * NTHREADS + tid, GT = gridDim.x * NTHREADS;
    { u32x4* z = (u32x4*)(p.ws + WS_WINE + (size_t)3600 * D * 2); for (int i = gtid; i < 240 * D / 8; i += GT) z[i] = (u32x4){0u, 0u, 0u, 0u}; }
    { float* cosT = (float*)(p.ws + WS_COS); float* sinT = (float*)(p.ws + WS_SIN);
      for (int i = gtid; i < 2056 * 128; i += GT) { const int pi = i >> 7, fi = i & 127; const int pos = pi < 2048 ? pi : 16384 + pi - 2048;
          const float inv = powf(10000.0f, -(float)fi / 128.0f); const float ang = (float)pos * inv;
          const double rev = (double)ang * 0.15915494309189533577; const float fr = (float)(rev - rint(rev));
          cosT[i] = __builtin_amdgcn_cosf(fr); sinT[i] = __builtin_amdgcn_sinf(fr); } }
    row_pass(p, 0, 0.f, nullptr, 0);
}

#define BSYNC() do { asm volatile("s_waitcnt vmcnt(0) lgkmcnt(0)" ::: "memory"); __syncthreads(); } while (0)
template <int TY> __device__ __forceinline__ void ma_even_item(const Params& p, ldsp lds, int item) {
    constexpr int DK = TY ? 128 : 64, NSEG = NTHREADS / DK, SEGL = 64 / NSEG;
    const int tid = otid(), lane = tid & 63, wave = __builtin_amdgcn_readfirstlane(tid >> 6), l15 = lane & 15, q4 = lane >> 4;
    const int bh = item >> 5, c = item & 31, b = bh >> 2, h = bh & 3, row0 = b * 2048 + c * 64;
    const int d = tid % DK, sg = tid / DK;
    LAS float* Bl = (LAS float*)lds; LAS float* SEG = (LAS float*)(lds + 32768); LAS float* LRs = (LAS float*)(lds + 36864);
    ldsp KHT = lds + 40960; ldsp VT = lds + 59392;
    const bf16_t* Pb = (const bf16_t*)(p.ws + WS_P) + (size_t)row0 * NE;
    if (TY == 0) { for (int idx = tid; idx < 1024; idx += NTHREADS) LRs[idx] = bf2f(Pb[(size_t)(idx >> 4) * NE + E_LR + (idx & 15)]); }
    stage_T<128>(VT, 72, Pb + (TY ? E_IB : E_VA) + h * 128, NE, wave, lane);
    float w2[16]; float bias = 0.f, lbv = 0.f;
    if (TY == 0) {
#pragma unroll
        for (int r = 0; r < 16; ++r) w2[r] = p.in[10][r * 256 + h * 64 + d];
        bias = p.in[11][h * 64 + d];
    } else { const float t0 = p.in[13][h * 128 + d], t1 = p.in[13][512 + h * 128 + d], t2 = p.in[13][1024 + h * 128 + d];
        const float mx = fmaxf(t0, fmaxf(t1, t2)); const float e0 = __expf(t0 - mx), e1 = __expf(t1 - mx), e2 = __expf(t2 - mx); lbv = e0 / (e0 + e1 + e2); }
    BSYNC();
    float run = 0.f;
#pragma unroll
    for (int i = 0; i < SEGL; ++i) { const int s = sg * SEGL + i; float g;
        if (TY == 0) { float x = bias;
#pragma unroll
            for (int r = 0; r < 16; ++r) x += LRs[s * 16 + r] * w2[r];
            g = logsig(x) * 0.0625f;
        } else { const float x = bf2f(Pb[(size_t)s * NE + E_FB + h * 128 + d]); const float sig = __builtin_amdgcn_rcpf(1.0f + __expf(-x)); g = __logf(lbv + (1.0f - lbv) * sig); }
        run += g; Bl[s * DK + d] = run; }
    SEG[sg * 128 + d] = run;
    BSYNC();
    float off = 0.f, tot = 0.f;
#pragma unroll
    for (int s2 = 0; s2 < NSEG; ++s2) { const float v = SEG[s2 * 128 + d]; if (s2 < sg) off += v; tot += v; }
#pragma unroll
    for (int i = 0; i < SEGL; ++i) Bl[(sg * SEGL + i) * DK + d] += off;
    BSYNC();
    const float bmid = Bl[31 * DK + d], blast = tot;
    bf16_t* QT = (bf16_t*)(p.ws + WS_QT); bf16_t* QH = (bf16_t*)(p.ws + WS_QH); bf16_t* KT = (bf16_t*)(p.ws + WS_KT);
    const int col = TY ? 256 + h * 128 + d : h * 64 + d;
#pragma unroll
    for (int i = 0; i < SEGL; ++i) { const int s = sg * SEGL + i; const float bs = Bl[s * DK + d]; float qv, kv;
        if (TY == 0) { qv = bf2f(Pb[(size_t)s * NE + E_QA + h * 64 + d]) * 0.125f; kv = bf2f(Pb[(size_t)s * NE + E_KA + h * 64 + d]); }
        else { qv = siluf(bf2f(Pb[(size_t)s * NE + E_QB + h * 128 + d])); const float xf = bf2f(Pb[(size_t)s * NE + E_FB + h * 128 + d]); kv = (1.0f - lbv) * __builtin_amdgcn_rcpf(1.0f + __expf(xf)); }
        const size_t g = (size_t)(row0 + s) * 768 + col;
        QT[g] = (bf16_t)f2bf(qv * __expf(fminf(bs - bmid, 80.f))); QH[g] = (bf16_t)f2bf(qv * __expf(bs)); KT[g] = (bf16_t)f2bf(kv * __expf(fminf(bmid - bs, 80.f)));
        *(LAS bf16_t*)(KHT + (size_t)(d * 72 + s) * 2) = (bf16_t)f2bf(kv * __expf(blast - bs)); }
    if (sg == 0) ((float*)(p.ws + WS_DEC + (TY ? DEC_HGRN : 0)))[(size_t)item * DK + d] = __expf(blast);
    BSYNC();
    f32x4 acc[DK / 16];
#pragma unroll
    for (int i = 0; i < DK / 16; ++i) acc[i] = (f32x4){0.f, 0.f, 0.f, 0.f};
#pragma unroll
    for (int ks = 0; ks < 2; ++ks) { const bf16x8 bf = ldfrag(VT, (16 * wave + l15) * 72 + 32 * ks + 8 * q4);
#pragma unroll
        for (int i = 0; i < DK / 16; ++i) acc[i] = mma16(ldfrag(KHT, (16 * i + l15) * 72 + 32 * ks + 8 * q4), bf, acc[i]); }
    bf16_t* HL = (bf16_t*)(p.ws + WS_HL + (TY ? HL_HGRN : 0)) + ((size_t)item * 128 + 16 * wave + l15) * DK;
#pragma unroll
    for (int i = 0; i < DK / 16; ++i) { u32x2 w; w.x = pk2(acc[i][0], acc[i][1]); w.y = pk2(acc[i][2], acc[i][3]); *(u32x2*)(HL + 16 * i + 4 * q4) = w; }
    BSYNC();
}

__device__ __forceinline__ void ma_ret_item(const Params& p, ldsp lds, int item) {
    const int tid = otid(), lane = tid & 63, wave = __builtin_amdgcn_readfirstlane(tid >> 6), l15 = lane & 15, q4 = lane >> 4;
    const int es = item & 3, sc = (item >> 2) & 7, bh = item >> 5, b = bh >> 2, h = bh & 3;
    ldsp KTt = lds; ldsp VTt = lds + 36864;
    const bf16_t* Pb = (const bf16_t*)(p.ws + WS_P);
    f32x4 acc[16];
#pragma unroll
    for (int i = 0; i < 16; ++i) acc[i] = (f32x4){0.f, 0.f, 0.f, 0.f};
    u32x4 kr[4], vr[2];
    { const size_t rowq = (size_t)b * 2048 + (sc * 4) * 64;
      ld_T<256>(kr, Pb + rowq * NO + O_K + h * 256, NO, wave, lane); ld_T<128>(vr, Pb + rowq * NO + O_V + h * 512 + es * 128, NO, wave, lane); }
    for (int j = 0; j < 4; ++j) { const size_t rowj = (size_t)b * 2048 + (sc * 4 + j) * 64;
        st_T<256>(KTt, 72, kr, wave, lane); st_T<128>(VTt, 72, vr, wave, lane);
        __syncthreads();
        if (j < 3) { const size_t rown = rowj + 64; ld_T<256>(kr, Pb + rown * NO + O_K + h * 256, NO, wave, lane); ld_T<128>(vr, Pb + rown * NO + O_V + h * 512 + es * 128, NO, wave, lane); }
#pragma unroll
        for (int ks = 0; ks < 2; ++ks) { const bf16x8 bf = ldfrag(VTt, (16 * wave + l15) * 72 + 32 * ks + 8 * q4);
#pragma unroll
            for (int i = 0; i < 16; ++i) acc[i] = mma16(ldfrag(KTt, (16 * i + l15) * 72 + 32 * ks + 8 * q4), bf, acc[i]); }
        __syncthreads(); }
    bf16_t* HL = (bf16_t*)(p.ws + WS_HL) + (((size_t)bh * 8 + sc) * 512 + es * 128 + 16 * wave + l15) * 256;
#pragma unroll
    for (int i = 0; i < 16; ++i) { u32x2 w; w.x = pk2(acc[i][0], acc[i][1]); w.y = pk2(acc[i][2], acc[i][3]); *(u32x2*)(HL + 16 * i + 4 * q4) = w; }
}

template <int DK, int DV, int NC, bool RET> __device__ __forceinline__ void scan_states(const bf16_t* HL, const float* DEC, bf16_t* ST, float* outp) {
    constexpr int DQ = DK / 4; constexpr int total = 32 * DV * DQ;
    const int tid_ = otid(); const int gtid = blockIdx.x * NTHREADS + tid_, GT = gridDim.x * NTHREADS;
    constexpr int PB = DV * DQ;
    const bool xm = gridDim.x == 256; const int lt = (blockIdx.x >> 3) * NTHREADS + tid_;
    const int niter = xm ? (4 * PB + 16383) / 16384 : (total + GT - 1) / GT;
    for (int it = 0; it < niter; ++it) {
        int dq, e, bh;
        if (xm) { const int j = lt + 16384 * it; if (j >= 4 * PB) break; bh = (blockIdx.x & 7) + 8 * (j / PB); const int rem = j % PB; e = rem / DQ; dq = rem % DQ; }
        else { const int idx = gtid + it * GT; if (idx >= total) break; dq = idx % DQ; e = (idx / DQ) % DV; bh = idx / (DQ * DV); }
        f32x4 S = (f32x4){0.f, 0.f, 0.f, 0.f}; float c_st = 1.f, c_dec = 1.f, c_h = 1.f;
        if (RET) { const float l2g = __log2f(1.0f - exp2f(-5.0f - (float)(bh & 3))); c_st = exp2f(129.f * l2g); c_dec = exp2f(256.f * l2g); c_h = exp2f(127.f * l2g); }
#pragma unroll 8
        for (int c = 0; c < NC; ++c) { const size_t base = (((size_t)bh * NC + c) * DV + e) * DK + dq * 4;
            u32x2 w; w.x = pk2(S[0] * c_st, S[1] * c_st); w.y = pk2(S[2] * c_st, S[3] * c_st); *(u32x2*)(ST + base) = w;
            const u32x2 hw = __builtin_nontemporal_load((const u32x2*)(HL + base)); const f32x4 hl = (f32x4){bf2f(hw.x & 0xffffu), bf2f(hw.x >> 16), bf2f(hw.y & 0xffffu), bf2f(hw.y >> 16)};
            f32x4 dec; if (RET) dec = (f32x4){c_dec, c_dec, c_dec, c_dec}; else dec = *(const f32x4*)(DEC + ((size_t)bh * NC + c) * DK + dq * 4);
            S = dec * S + hl * c_h; }
#pragma unroll
        for (int j = 0; j < 4; ++j) outp[((size_t)bh * DK + dq * 4 + j) * DV + e] = S[j];
    }
}

template <int TY> __device__ __forceinline__ void mc_item(const Params& p, ldsp lds, int item) {
    constexpr int DK = TY == 0 ? 64 : (TY == 1 ? 128 : 256), DV = TY == 2 ? 512 : 128, NB = TY == 2 ? 4 : 1, ET = DV / 128, PQ = DK + 8;
    constexpr int szQ = 64 * PQ * 2, o_qh = szQ, o_kt = (TY == 2 ? 1 : 2) * szQ, o_vt = o_kt + szQ, o_pm = o_vt + DV * 144, o_red = o_pm + 64 * 144;
    static_assert(o_red + 2048 <= LDS_BYTES, "mc LDS");
    const int tid = otid(), lane = tid & 63, wave = __builtin_amdgcn_readfirstlane(tid >> 6), l15 = lane & 15, q4 = lane >> 4;
    const int bh = item >> 5, c = item & 31, b = bh >> 2, h = bh & 3, sc = c / NB, jc = c % NB, row0 = b * 2048 + c * 64;
#ifdef LDSSHIFT
    if (TY != 2) lds += LDSSHIFT;
#endif
    ldsp QX = lds, QH2 = lds + o_qh, KTs = lds + o_kt, VTs = lds + o_vt, Pm = lds + o_pm; LAS float* RED = (LAS float*)(lds + o_red);
    const bf16_t* Pb = (const bf16_t*)(p.ws + WS_P);
    constexpr int PP = TY == 2 ? NO : NE;
    const int ecol = TY ? 256 + h * 128 : h * 64;
    if (TY == 2) stage_rows<DK>(QX, PQ, Pb + (size_t)row0 * NO + O_Q + h * 256, NO, tid);
    else { stage_rows<DK>(QX, PQ, (const bf16_t*)(p.ws + WS_QT) + (size_t)row0 * 768 + ecol, 768, tid);
           stage_rows<DK>(QH2, PQ, (const bf16_t*)(p.ws + WS_QH) + (size_t)row0 * 768 + ecol, 768, tid); }
    f32x4 acc[ET][4];
#pragma unroll
    for (int ei = 0; ei < ET; ++ei)
#pragma unroll
        for (int tk = 0; tk < 4; ++tk) acc[ei][tk] = (f32x4){0.f, 0.f, 0.f, 0.f};
    const int voff = TY == 0 ? E_VA + h * 128 : (TY == 1 ? E_IB + h * 128 : O_V + h * 512);
    const int tt = wave & 3, sp = wave >> 2;
    u32x4 kr[TY == 2 ? 4 : 1], vr[TY == 2 ? 8 : 1];
    if constexpr (TY == 2) { const size_t rowq = (size_t)b * 2048 + (sc * NB) * 64;
        ld_rows<256>(kr, Pb + rowq * NO + O_K + h * 256, NO, tid); ld_T<512>(vr, Pb + rowq * NO + voff, NO, wave, lane); }
    for (int j = 0; j <= jc; ++j) { const size_t rowj = (size_t)b * 2048 + (sc * NB + j) * 64;
        if constexpr (TY == 2) { st_rows<256>(KTs, PQ, kr, tid); st_T<512>(VTs, 72, vr, wave, lane); }
        else { stage_rows<DK>(KTs, PQ, (const bf16_t*)(p.ws + WS_KT) + rowj * 768 + ecol, 768, tid);
               stage_T<DV>(VTs, 72, Pb + rowj * PP + voff, PP, wave, lane); }
        if constexpr (TY == 2) { __syncthreads(); if (j < jc) { const size_t rown = rowj + 64; ld_rows<256>(kr, Pb + rown * NO + O_K + h * 256, NO, tid); ld_T<512>(vr, Pb + rown * NO + voff, NO, wave, lane); } }
        else BSYNC();
        { f32x4 c0 = (f32x4){0.f, 0.f, 0.f, 0.f}, c1 = c0;
#pragma unroll
          for (int ks = 0; ks < DK / 32; ++ks) { const bf16x8 bq = ldfrag(QX, (16 * tt + l15) * PQ + 32 * ks + 8 * q4);
              c0 = mma16(ldfrag(KTs, (16 * (2 * sp) + l15) * PQ + 32 * ks + 8 * q4), bq, c0);
              c1 = mma16(ldfrag(KTs, (16 * (2 * sp + 1) + l15) * PQ + 32 * ks + 8 * q4), bq, c1); }
          const int t = 16 * tt + l15;
          const int tl = (j == jc) ? t : 4096;
#pragma unroll
          for (int jj = 0; jj < 4; ++jj) { if (32 * sp + 4 * q4 + jj > tl) c0[jj] = 0.f; if (32 * sp + 16 + 4 * q4 + jj > tl) c1[jj] = 0.f; }
          u32x2 w; w.x = pk2(c0[0], c0[1]); w.y = pk2(c0[2], c0[3]); *(LAS u32x2*)(Pm + (size_t)(t * 72 + 32 * sp + 4 * q4) * 2) = w;
          w.x = pk2(c1[0], c1[1]); w.y = pk2(c1[2], c1[3]); *(LAS u32x2*)(Pm + (size_t)(t * 72 + 32 * sp + 16 + 4 * q4) * 2) = w; }
        if constexpr (TY == 2) __syncthreads(); else BSYNC();
#pragma unroll
        for (int ks = 0; ks < 2; ++ks) { bf16x8 pb[4];
#pragma unroll
            for (int tk = 0; tk < 4; ++tk) pb[tk] = ldfrag(Pm, (16 * tk + l15) * 72 + 32 * ks + 8 * q4);
#pragma unroll
            for (int ei = 0; ei < ET; ++ei) { const bf16x8 va = ldfrag(VTs, (16 * (wave * ET + ei) + l15) * 72 + 32 * ks + 8 * q4);
#pragma unroll
                for (int tk = 0; tk < 4; ++tk) acc[ei][tk] = mma16(va, pb[tk], acc[ei][tk]); } }
        if constexpr (TY == 2) __syncthreads(); else BSYNC(); }
    if ((TY == 2 ? sc : c) != 0) { const bf16_t* STp = (TY == 2) ? (const bf16_t*)(p.ws + WS_ST) + ((size_t)bh * 8 + sc) * 512 * 256
                                    : (const bf16_t*)(p.ws + WS_ST + (TY ? ST_HGRN : 0)) + ((size_t)bh * 32 + c) * 128 * DK;
      ldsp QS = (TY == 2) ? QX : QH2;
      bf16x8 sa[ET], sn[ET];
#pragma unroll
      for (int ei = 0; ei < ET; ++ei) sa[ei] = *(const bf16x8*)(STp + (size_t)(16 * (wave * ET + ei) + l15) * DK + 8 * q4);
#pragma unroll 1
      for (int ks = 0; ks < DK / 32; ++ks) { bf16x8 qb[4];
          const int kn = (ks + 1 < DK / 32) ? ks + 1 : ks;
#pragma unroll
          for (int ei = 0; ei < ET; ++ei) sn[ei] = *(const bf16x8*)(STp + (size_t)(16 * (wave * ET + ei) + l15) * DK + 32 * kn + 8 * q4);
#pragma unroll
          for (int tk = 0; tk < 4; ++tk) qb[tk] = ldfrag(QS, (16 * tk + l15) * PQ + 32 * ks + 8 * q4);
#pragma unroll
          for (int ei = 0; ei < ET; ++ei) {
#pragma unroll
              for (int tk = 0; tk < 4; ++tk) acc[ei][tk] = mma16(sa[ei], qb[tk], acc[ei][tk]); }
#pragma unroll
          for (int ei = 0; ei < ET; ++ei) sa[ei] = sn[ei]; } }
    if (TY == 2 && (DBGSKIP & 4)) {
#pragma unroll
        for (int ei = 0; ei < ET; ++ei)
#pragma unroll
            for (int tk = 0; tk < 4; ++tk)
#pragma unroll
                for (int jj = 0; jj < 4; ++jj) acc[ei][tk][jj] = (float)((16 * (wave * ET + ei) + 4 * q4 + jj + 3 * (16 * tk + l15) + row0) & 15) - 7.5f;
    }
    float rstd[4];
#pragma unroll
    for (int tk = 0; tk < 4; ++tk) { float s = 0.f;
#pragma unroll
        for (int ei = 0; ei < ET; ++ei) { const f32x4 v = acc[ei][tk]; s += (v[0] * v[0] + v[1] * v[1]) + (v[2] * v[2] + v[3] * v[3]); }
        s += __shfl_xor(s, 16); s += __shfl_xor(s, 32);
        if (q4 == 0) RED[wave * 64 + 16 * tk + l15] = s; }
    BSYNC();
#pragma unroll
    for (int tk = 0; tk < 4; ++tk) { float s = 0.f;
#pragma unroll
        for (int w = 0; w < 8; ++w) s += RED[w * 64 + 16 * tk + l15];
        rstd[tk] = rsqrtf(s * (1.0f / DV) + EPS); }
    const float* nwp = TY == 0 ? p.in[12] : (TY == 1 ? p.in[14] : p.in[17]);
    const int goff = TY == 0 ? E_RA + h * 128 : (TY == 1 ? E_GB + h * 128 : O_G + h * 512);
    constexpr int LDY = TY == 2 ? 2048 : 1024; const int ycol = TY == 0 ? h * 128 : (TY == 1 ? 512 + h * 128 : h * 512);
    bf16_t* Y = (bf16_t*)(p.ws + WS_Y);
#pragma unroll
    for (int ei = 0; ei < ET; ++ei) { const int e0 = 16 * (wave * ET + ei) + 4 * q4; const f32x4 w4 = *(const f32x4*)(nwp + e0);
#pragma unroll
        for (int tk = 0; tk < 4; ++tk) { const size_t row = (size_t)row0 + 16 * tk + l15;
            const u32x2 gw = *(const u32x2*)(Pb + row * PP + goff + e0);
            const float g0 = bf2f(gw.x & 0xffffu), g1 = bf2f(gw.x >> 16), g2 = bf2f(gw.y & 0xffffu), g3 = bf2f(gw.y >> 16);
            const f32x4 v = acc[ei][tk] * rstd[tk] * w4;
            float y0 = v[0] * siluf(g0), y1 = v[1] * siluf(g1), y2 = v[2] * siluf(g2), y3 = v[3] * siluf(g3);
#ifdef NANFIX
            if (!(fabsf(y0) < 1e30f)) y0 = 0.f; if (!(fabsf(y1) < 1e30f)) y1 = 0.f; if (!(fabsf(y2) < 1e30f)) y2 = 0.f; if (!(fabsf(y3) < 1e30f)) y3 = 0.f;
#endif
            u32x2 o; o.x = pk2(y0, y1); o.y = pk2(y2, y3);
            *(u32x2*)(Y + row * LDY + ycol + e0) = o; } }
    BSYNC();
}

template <int TY> __device__ __forceinline__ void sample_item(const Params& p, ldsp lds, int item) {
    constexpr int DK = TY == 0 ? 64 : (TY == 1 ? 128 : 256), DV = TY == 2 ? 512 : 128, E4 = DV / 4, NG = NTHREADS / E4, PP = TY == 2 ? NO : NE;
    const int tid = otid(), lane = tid & 63, wave = __builtin_amdgcn_readfirstlane(tid >> 6);
    const int b = item >> 2, h = item & 3, r0 = MP + b * 8;
    LAS float* QK = (LAS float*)lds; LAS float* Bs = (LAS float*)(lds + 16384); LAS float* QR = (LAS float*)(lds + 24576); LAS float* KR = (LAS float*)(lds + 32768);
    LAS float* DECs = (LAS float*)(lds + 40960); LAS float* As = (LAS float*)(lds + 41984); LAS float* Vs = (LAS float*)(lds + 42240); LAS float* OP = (LAS float*)(lds + 58624);
    static_assert(58624 + 65536 <= LDS_BYTES, "sample LDS");
    const bf16_t* Pb = (const bf16_t*)(p.ws + WS_P) + (size_t)r0 * PP;
    const int voff = TY == 0 ? E_VA + h * 128 : (TY == 1 ? E_IB + h * 128 : O_V + h * 512);
    for (int idx = tid; idx < 8 * DV; idx += NTHREADS) { const int t = idx / DV, e = idx % DV; Vs[idx] = bf2f(Pb[(size_t)t * PP + voff + e]); }
    if (tid < DK) { const int d = tid;
        float w2[16]; float bias = 0.f, lbv = 0.f, lng = 0.f;
        if (TY == 0) {
#pragma unroll
            for (int r = 0; r < 16; ++r) w2[r] = p.in[10][r * 256 + h * 64 + d];
            bias = p.in[11][h * 64 + d];
        } else if (TY == 1) { const float t0 = p.in[13][h * 128 + d], t1 = p.in[13][512 + h * 128 + d], t2 = p.in[13][1024 + h * 128 + d];
            const float mx = fmaxf(t0, fmaxf(t1, t2)); const float e0 = __expf(t0 - mx), e1 = __expf(t1 - mx), e2 = __expf(t2 - mx); lbv = e0 / (e0 + e1 + e2);
        } else lng = __logf(1.0f - exp2f(-5.0f - (float)h));
        float run = 0.f; float bt[8], qv[8], kv[8];
#pragma unroll
        for (int t = 0; t < 8; ++t) { float g;
            if (TY == 0) { float x = bias;
#pragma unroll
                for (int r = 0; r < 16; ++r) x += bf2f(Pb[(size_t)t * NE + E_LR + r]) * w2[r];
                g = logsig(x) * 0.0625f; qv[t] = bf2f(Pb[(size_t)t * NE + E_QA + h * 64 + d]) * 0.125f; kv[t] = bf2f(Pb[(size_t)t * NE + E_KA + h * 64 + d]);
            } else if (TY == 1) { const float xf = bf2f(Pb[(size_t)t * NE + E_FB + h * 128 + d]); const float sig = __builtin_amdgcn_rcpf(1.0f + __expf(-xf));
                g = __logf(lbv + (1.0f - lbv) * sig); kv[t] = (1.0f - lbv) * __builtin_amdgcn_rcpf(1.0f + __expf(xf)); qv[t] = siluf(bf2f(Pb[(size_t)t * NE + E_QB + h * 128 + d]));
            } else { g = lng; qv[t] = bf2f(Pb[(size_t)t * NO + O_Q + h * 256 + d]); kv[t] = bf2f(Pb[(size_t)t * NO + O_K + h * 256 + d]); }
            run += g; bt[t] = run; }
#pragma unroll
        for (int t = 0; t < 8; ++t) { Bs[t * DK + d] = bt[t]; QR[t * DK + d] = qv[t]; KR[t * DK + d] = kv[t];
            QK[d * 16 + t] = qv[t] * __expf(bt[t]); QK[d * 16 + 8 + t] = kv[t] * __expf(run - bt[t]); }
        DECs[d] = __expf(run); }
    BSYNC();
    { const int pq = tid & 63, part = tid >> 6, t = pq >> 3, s = pq & 7;
      float a = 0.f;
      if (s <= t) { for (int d = part; d < DK; d += 8) a += QR[t * DK + d] * KR[s * DK + d] * __expf(Bs[t * DK + d] - Bs[s * DK + d]); }
      OP[part * 64 + pq] = a; }
    BSYNC();
    if (tid < 64) { float a = 0.f;
#pragma unroll
        for (int q = 0; q < 8; ++q) a += OP[q * 64 + tid];
        As[tid] = a; }
    BSYNC();
    const int e4 = tid % E4, dg = tid / E4;
    f32x4 v[8], o[8];
#pragma unroll
    for (int t = 0; t < 8; ++t) { v[t] = *(const LAS f32x4*)(Vs + t * DV + e4 * 4); o[t] = (f32x4){0.f, 0.f, 0.f, 0.f}; }
    const float* S0 = (TY == 0 ? p.in[2] : (TY == 1 ? p.in[3] : p.in[4])) + (size_t)item * DK * DV;
    float* S1 = p.out + (TY == 0 ? OUT_GLA_S : (TY == 1 ? OUT_HGRN_S : OUT_RET_S)) + (size_t)item * DK * DV;
#pragma unroll 8
    for (int d = dg; d < DK; d += NG) { const f32x4 s0 = __builtin_nontemporal_load((const f32x4*)(S0 + (size_t)d * DV + e4 * 4));
        const f32x4 qa = *(const LAS f32x4*)(QK + d * 16), qb = *(const LAS f32x4*)(QK + d * 16 + 4), ka = *(const LAS f32x4*)(QK + d * 16 + 8), kb = *(const LAS f32x4*)(QK + d * 16 + 12);
        const float dc = DECs[d];
        o[0] += s0 * qa[0]; o[1] += s0 * qa[1]; o[2] += s0 * qa[2]; o[3] += s0 * qa[3]; o[4] += s0 * qb[0]; o[5] += s0 * qb[1]; o[6] += s0 * qb[2]; o[7] += s0 * qb[3];
        f32x4 sn = s0 * dc; sn += v[0] * ka[0]; sn += v[1] * ka[1]; sn += v[2] * ka[2]; sn += v[3] * ka[3]; sn += v[4] * kb[0]; sn += v[5] * kb[1]; sn += v[6] * kb[2]; sn += v[7] * kb[3];
        __builtin_nontemporal_store(sn, (f32x4*)(S1 + (size_t)d * DV + e4 * 4)); }
#pragma unroll
    for (int t = 0; t < 8; ++t) *(LAS f32x4*)(OP + (dg * 8 + t) * DV + e4 * 4) = o[t];
    BSYNC();
    { const int t = wave; float val[DV / 64]; float ssq = 0.f;
#pragma unroll
      for (int i = 0; i < DV / 64; ++i) { const int e = lane + 64 * i; float a = 0.f;
          for (int g = 0; g < NG; ++g) a += OP[(g * 8 + t) * DV + e];
          for (int s = 0; s <= t; ++s) a += As[t * 8 + s] * Vs[s * DV + e];
          val[i] = a; ssq += a * a; }
      ssq = wave_sum(ssq); const float rstd = rsqrtf(ssq * (1.0f / DV) + EPS);
      const float* nwp = TY == 0 ? p.in[12] : (TY == 1 ? p.in[14] : p.in[17]);
      const int goff = TY == 0 ? E_RA + h * 128 : (TY == 1 ? E_GB + h * 128 : O_G + h * 512);
      constexpr int LDY = TY == 2 ? 2048 : 1024; const int ycol = TY == 0 ? h * 128 : (TY == 1 ? 512 + h * 128 : h * 512);
      bf16_t* Y = (bf16_t*)(p.ws + WS_Y) + (size_t)(r0 + t) * LDY + ycol;
#pragma unroll
      for (int i = 0; i < DV / 64; ++i) { const int e = lane + 64 * i; const float g = bf2f(Pb[(size_t)t * PP + goff + e]);
          Y[e] = (bf16_t)f2bf(val[i] * rstd * nwp[e] * siluf(g)); } }
    BSYNC();
}

#define XB_TMO      128
#define XB_XCNT(j)  (256  + 64 * (j))
#define XB_XSUB(j)  (1280 + 64 * (j))
#define XB_XGEN(j)  (2304 + 64 * (j))
#define XB_TOP      3328
#define XB_TOPGEN   3392
#define XCD_BAR_WORDS 3456
#define XB_SPIN_CAP (1u << 18)

__device__ __forceinline__ unsigned xb_ld(unsigned* p)              { return __hip_atomic_load(p, __ATOMIC_RELAXED, __HIP_MEMORY_SCOPE_AGENT); }
__device__ __forceinline__ unsigned xb_add(unsigned* p, unsigned v) { return __hip_atomic_fetch_add(p, v, __ATOMIC_RELAXED, __HIP_MEMORY_SCOPE_AGENT); }
__device__ __forceinline__ unsigned xb_xcc_id() { return (unsigned)__builtin_amdgcn_s_getreg((3 << 11) | 20) & 0xFu; }
#define XB_SPIN(cond, bar) do { unsigned _sp = 0; while (cond) { __builtin_amdgcn_s_sleep(1); \
    if ((++_sp & 255u) == 0u) { if (xb_ld(&(bar)[XB_TMO])) break; if (_sp > XB_SPIN_CAP) { atomicAdd(&(bar)[XB_TMO], 1u); break; } } } } while (0)
struct XcdBarrier {
    unsigned* bar; unsigned x;
    volatile LAS unsigned* st;
};

__device__ __forceinline__ XcdBarrier xcd_barrier_post(unsigned* bar, volatile LAS unsigned* st) {
    XcdBarrier b; b.bar = bar; b.x = xb_xcc_id(); b.st = st;
    if (threadIdx.x == 0) (void)xb_add(&bar[XB_XCNT(b.x)], 1u);
    return b;
}
__device__ __forceinline__ void xcd_barrier_complete(unsigned* bar, unsigned x, unsigned& nloc, unsigned& nx) {
    const unsigned G = gridDim.x * gridDim.y * gridDim.z;
    unsigned sum, cnt, mine, sp = 0u;
    for (;;) {
        sum = 0u; cnt = 0u; mine = 0u;
#pragma unroll
        for (unsigned j = 0; j < 16; ++j) { const unsigned c = xb_ld(&bar[XB_XCNT(j)]); sum += c; cnt += (c > 0u) ? 1u : 0u; mine = (j == x) ? c : mine; }
        if (sum == G) break;
        __builtin_amdgcn_s_sleep(1);
        if ((++sp & 255u) == 0u) { if (xb_ld(&bar[XB_TMO])) break; if (sp > XB_SPIN_CAP) { atomicAdd(&bar[XB_TMO], 1u); break; } }
    }
    nloc = mine > 0u ? mine : 1u; nx = cnt > 0u ? cnt : 1u;
}

__device__ __forceinline__ void xcd_barrier(const XcdBarrier& b) {
    asm volatile("s_waitcnt vmcnt(0)" ::: "memory");
    __syncthreads();
    if (threadIdx.x == 0) {
        unsigned* bar = b.bar;
        __builtin_amdgcn_s_waitcnt(0);
        unsigned nloc = b.st[0], nx = b.st[1];
        if (nloc == 0u) { xcd_barrier_complete(bar, b.x, nloc, nx); b.st[0] = nloc; b.st[1] = nx; }
        const unsigned old = xb_add(&bar[XB_XSUB(b.x)], 1u);
        const unsigned gen = old / nloc;
        if (old + 1u == (gen + 1u) * nloc) {
            __builtin_amdgcn_fence(__ATOMIC_RELEASE, "agent");
            asm volatile("s_waitcnt vmcnt(0)" ::: "memory");
            const unsigned og = xb_add(&bar[XB_TOP], 1u);
            const unsigned tg = og / nx;
            if (og + 1u == (tg + 1u) * nx) xb_add(&bar[XB_TOPGEN], 1u);
            else XB_SPIN(xb_ld(&bar[XB_TOPGEN]) == tg, bar);
            __builtin_amdgcn_fence(__ATOMIC_ACQUIRE, "agent");
            xb_add(&bar[XB_XGEN(b.x)], 1u);
            asm volatile("s_waitcnt vmcnt(0)" ::: "memory");
        } else {
            XB_SPIN(xb_ld(&bar[XB_XGEN(b.x)]) == gen, bar);
            __builtin_amdgcn_fence(__ATOMIC_ACQUIRE, "agent");
            asm volatile("s_waitcnt vmcnt(0)" ::: "memory");
        }
    }
    __syncthreads();
}

__device__ __forceinline__ unsigned char* ows(const Params& p) { unsigned char* w = p.ws; asm volatile("" : "+s"(w)); return w; }
__device__ __forceinline__ void gsync(cg::grid_group& grid) {
    asm volatile("s_waitcnt vmcnt(0) lgkmcnt(0)" ::: "memory");
    grid.sync();
    __builtin_amdgcn_fence(__ATOMIC_ACQUIRE, "agent");
    asm volatile("s_waitcnt vmcnt(0)" ::: "memory");
}
__global__ void __launch_bounds__(NTHREADS, 2) fwd_megakernel(Params p) {
    extern __shared__ __attribute__((aligned(16))) unsigned char lds_raw[];
    cg::grid_group grid = cg::this_grid();
    ldsp lds = (ldsp)lds_raw;
    const int G = gridDim.x, bid = blockIdx.x;
    volatile LAS unsigned* xst = (volatile LAS unsigned*)(lds + LDS_BYTES - 16);
    if (threadIdx.x == 0) { xst[0] = 0u; xst[1] = 0u; xst[2] = 0u; xst[3] = 0u; }
    __syncthreads();
    (void)xcd_barrier_post((unsigned*)(p.ws + WS_BAR), xst);
#define XSYNC() do { XcdBarrier xb_; xb_.bar = (unsigned*)(p.ws + WS_BAR); xb_.x = xb_xcc_id(); xb_.st = (volatile LAS unsigned*)(lds + LDS_BYTES - 16); xcd_barrier(xb_); } while (0)

    prologue(p, lds);
#if REP_P0 > 1
    prologue(p, lds);
#endif
    XSYNC();
#pragma unroll 1
    for (int f = 0; f < 4; ++f) { const int l = f >> 1, j = f & 1;
        { unsigned char* ws = ows(p); pg8::Gemm g{(const bf16_t*)(ws + WS_XB), (const bf16_t*)(ws + WS_WUP + f * SZ_WUP), M, NUP, D, D}; pg8::StaticOrder S; S.init(M, NUP, G, bid, TREP_UP);
          pg8::EpiSwiGLU E{(bf16_t*)(ws + WS_ACT), (const float*)(ws + WS_RS)}; pg8::gemm_phase<pg8::EpiSwiGLU, pg8::StaticOrder, true, true>(lds, g, S, E);
#if REP_UP > 1
                  pg8::gemm_phase<pg8::EpiSwiGLU, pg8::StaticOrder, true, true>(lds, g, S, E);
#endif
                }
        XSYNC();
        { unsigned char* ws = ows(p); pg8::Gemm g{(const bf16_t*)(ws + WS_ACT), (const bf16_t*)(ws + WS_WDN + f * SZ_WDN), MP, D, FF, FF}; pg8::StaticOrder S; S.init(MP, D, G, bid, TREP_DN);
          pg8::EpiB16 E{(bf16_t*)(ws + WS_F)}; pg8::gemm_phase<pg8::EpiB16, pg8::StaticOrder, true, true>(lds, g, S, E); }
        { unsigned char* ws = ows(p); pg8::Gemm g{(const bf16_t*)(ws + WS_ACT), (const bf16_t*)(ws + WS_WDN + f * SZ_WDN), M, D, 256, FF}; pg8::SplitOrder S; S.init(11, G, bid);
          pg8::EpiPart E{(float*)(ws + WS_PART)}; pg8::gemm_phase<pg8::EpiPart, pg8::SplitOrder, true, true>(lds, g, S, E); }
        XSYNC();
        if (PHMASK & 8) row_pass(p, f == 3 ? 2 : 1, 0.5f, p.in[5] + (l * 6 + (j ? 5 : 1)) * D, 11);
        if (f == 3) { if (p.ws == nullptr) gsync(grid);     break; }
        XSYNC();
        if (j == 0) {
            if (l == 0) {
                { unsigned char* ws = ows(p); pg8::Gemm g{(const bf16_t*)(ws + WS_XB), (const bf16_t*)(ws + WS_WINE), M, NE, D, D}; pg8::StaticOrder S; S.init(M, NE, G, bid, TREP_IN);
                  pg8::EpiScale E{(bf16_t*)(ws + WS_P), NE, (const float*)(ws + WS_RS)}; pg8::gemm_phase<pg8::EpiScale, pg8::StaticOrder, true, true>(lds, g, S, E);
#if REP_G > 1
                  pg8::gemm_phase<pg8::EpiScale, pg8::StaticOrder, true, true>(lds, g, S, E);
#endif
                }
                XSYNC();
                for (int it = bid; it < 1024; it += G) { if (it < 512) sample_item<0>(p, lds, it); else sample_item<1>(p, lds, it - 512); }
                if (G == 256) { for (int k = 0; k < 8; ++k) { const int item = (((bid & 7) + 8 * (k & 3)) << 5) + (bid >> 3); if (k < 4) ma_even_item<0>(p, lds, item); else ma_even_item<1>(p, lds, item); } }
                else for (int it = bid; it < 2048; it += G) { if (it < 1024) ma_even_item<0>(p, lds, it); else ma_even_item<1>(p, lds, it - 1024); }
#if REP_ME > 1
                if (G == 256) { for (int k = 0; k < 8; ++k) { const int item = (((bid & 7) + 8 * (k & 3)) << 5) + (bid >> 3); if (k < 4) ma_even_item<0>(p, lds, item); else ma_even_item<1>(p, lds, item); } }
                else for (int it = bid; it < 2048; it += G) { if (it < 1024) ma_even_item<0>(p, lds, it); else ma_even_item<1>(p, lds, it - 1024); }
#endif
                XSYNC();
                scan_states<64, 128, 32, false>((const bf16_t*)(p.ws + WS_HL), (const float*)(p.ws + WS_DEC), (bf16_t*)(p.ws + WS_ST), p.out + OUT_GLA_P);
#if REP_ME > 1
                scan_states<64, 128, 32, false>((const bf16_t*)(p.ws + WS_HL), (const float*)(p.ws + WS_DEC), (bf16_t*)(p.ws + WS_ST), p.out + OUT_GLA_P);
#endif
                scan_states<128, 128, 32, false>((const bf16_t*)(p.ws + WS_HL + HL_HGRN), (const float*)(p.ws + WS_DEC + DEC_HGRN), (bf16_t*)(p.ws + WS_ST + ST_HGRN), p.out + OUT_HGRN_P);
#if REP_ME > 1
                scan_states<128, 128, 32, false>((const bf16_t*)(p.ws + WS_HL + HL_HGRN), (const float*)(p.ws + WS_DEC + DEC_HGRN), (bf16_t*)(p.ws + WS_ST + ST_HGRN), p.out + OUT_HGRN_P);
#endif
                XSYNC();
                if (G == 256) { for (int k = 0; k < 8; ++k) { const int item = (((bid & 7) + 8 * (k & 3)) << 5) + (bid >> 3); if (k < 4) mc_item<0>(p, lds, item); else mc_item<1>(p, lds, item); } }
                else for (int it = bid; it < 2048; it += G) { if (it < 1024) mc_item<0>(p, lds, it); else mc_item<1>(p, lds, it - 1024); }
#if REP_ME > 1
                if (G == 256) { for (int k = 0; k < 8; ++k) { const int item = (((bid & 7) + 8 * (k & 3)) << 5) + (bid >> 3); if (k < 4) mc_item<0>(p, lds, item); else mc_item<1>(p, lds, item); } }
                else for (int it = bid; it < 2048; it += G) { if (it < 1024) mc_item<0>(p, lds, it); else mc_item<1>(p, lds, it - 1024); }
#endif
            } else {
                { unsigned char* ws = ows(p); pg8::Gemm g{(const bf16_t*)(ws + WS_XB), (const bf16_t*)(ws + WS_WINO), M, NO, D, D}; pg8::StaticOrder S; S.init(M, NO, G, bid, TREP_IN);
                  pg8::EpiRet E{(bf16_t*)(ws + WS_P), (const float*)(ws + WS_RS), (const float*)(ws + WS_COS), (const float*)(ws + WS_SIN)}; pg8::gemm_phase<pg8::EpiRet, pg8::StaticOrder, true, true>(lds, g, S, E);
#if REP_G > 1
                  pg8::gemm_phase<pg8::EpiRet, pg8::StaticOrder, true, true>(lds, g, S, E);
#endif
                }
                XSYNC();
                for (int it = bid; it < 512; it += G) sample_item<2>(p, lds, it);
                if (G == 256) { const int xq = bid & 7, yq = bid >> 3;
                    for (int k = 0; k < 4; ++k) { const int q = k * 64 + xq * 8 + (yq >> 2); ma_ret_item(p, lds, q * 4 + (yq & 3)); } }
                else for (int it = bid; it < 1024; it += G) ma_ret_item(p, lds, it);
#if REP_OA > 1
                if (G == 256) { const int xq = bid & 7, yq = bid >> 3;
                    for (int k = 0; k < 4; ++k) { const int q = k * 64 + xq * 8 + (yq >> 2); ma_ret_item(p, lds, q * 4 + (yq & 3)); } }
                else for (int it = bid; it < 1024; it += G) ma_ret_item(p, lds, it);
#endif
                XSYNC();
                scan_states<256, 512, 8, true>((const bf16_t*)(p.ws + WS_HL), nullptr, (bf16_t*)(p.ws + WS_ST), p.out + OUT_RET_P);
#if REP_OB > 1
                scan_states<256, 512, 8, true>((const bf16_t*)(p.ws + WS_HL), nullptr, (bf16_t*)(p.ws + WS_ST), p.out + OUT_RET_P);
#endif
                XSYNC();
                if (G == 256) { const int xq = bid & 7, yq = bid >> 3;
                    for (int k = 0; k < 4; ++k) { const int q = k * 64 + xq * 8 + (yq >> 2), jcq = ((yq & 3) + k) & 3; mc_item<2>(p, lds, (q >> 3) * 32 + (q & 7) * 4 + jcq); } }
                else for (int it = bid; it < 1024; it += G) mc_item<2>(p, lds, (it & ~31) | (((it & 31) + (it >> 8)) & 31));
#if REP_OC > 1
                if (G == 256) { const int xq = bid & 7, yq = bid >> 3;
                    for (int k = 0; k < 4; ++k) { const int q = k * 64 + xq * 8 + (yq >> 2), jcq = ((yq & 3) + k) & 3; mc_item<2>(p, lds, (q >> 3) * 32 + (q & 7) * 4 + jcq); } }
                else for (int it = bid; it < 1024; it += G) mc_item<2>(p, lds, (it & ~31) | (((it & 31) + (it >> 8)) & 31));
#endif
            }
            XSYNC();
            { unsigned char* ws = ows(p); const int KO = l == 0 ? 1024 : 2048; pg8::Gemm g{(const bf16_t*)(ws + WS_Y), (const bf16_t*)(ws + (l == 0 ? WS_WOUTE : WS_WOUTO)), MP, D, KO, KO}; pg8::StaticOrder S; S.init(MP, D, G, bid);
              pg8::EpiB16 E{(bf16_t*)(ws + WS_F)}; pg8::gemm_phase<pg8::EpiB16, pg8::StaticOrder, true, true>(lds, g, S, E); }
            { unsigned char* ws = ows(p); const int KO = l == 0 ? 1024 : 2048; pg8::Gemm g{(const bf16_t*)(ws + WS_Y), (const bf16_t*)(ws + (l == 0 ? WS_WOUTE : WS_WOUTO)), M, D, 256, KO}; pg8::SplitOrder S; S.init(KO / 256, G, bid);
              pg8::EpiPart E{(float*)(ws + WS_PART)}; pg8::gemm_phase<pg8::EpiPart, pg8::SplitOrder, true, true>(lds, g, S, E); }
            XSYNC();
            if (PHMASK & 32768) row_pass(p, 1, 1.0f, p.in[5] + (l * 6 + 3) * D, l == 0 ? 4 : 8);
            XSYNC();
        }
    }
}

extern "C" void kernel_launch(void* const* d_in, const int* in_sizes, int n_in, void* d_out, int out_size, void* d_ws, size_t ws_size, hipStream_t stream) {
    static int grid = 0;
    if (grid == 0) {
        if (n_in != 19 || ws_size < WS_END) { fprintf(stderr, "kernel_launch: unexpected n_in %d / ws %zu (need %zu)\n", n_in, ws_size, (size_t)WS_END); grid = -1; return; }
        int dev = 0, cus = 0, per_cu = 0;
        (void)hipGetDevice(&dev); (void)hipDeviceGetAttribute(&cus, hipDeviceAttributeMultiprocessorCount, dev);
        if (hipFuncSetAttribute((const void*)fwd_megakernel, hipFuncAttributeMaxDynamicSharedMemorySize, LDS_BYTES) != hipSuccess) { fprintf(stderr, "kernel_launch: hipFuncSetAttribute failed\n"); grid = -1; return; }
        if (hipOccupancyMaxActiveBlocksPerMultiprocessor(&per_cu, (const void*)fwd_megakernel, NTHREADS, LDS_BYTES) != hipSuccess || per_cu < 1) { fprintf(stderr, "kernel_launch: occupancy query says %d\n", per_cu); per_cu = 1; }
        (void)hipGetLastError();
        grid = cus * per_cu;
    }
    if (grid < 0) return;
    Params p{};
    for (int i = 0; i < 19; ++i) p.in[i] = (const float*)d_in[i];
    p.out = (float*)d_out; p.ws = (unsigned char*)d_ws;
    if (hipMemsetAsync((char*)d_ws + WS_BAR, 0, 16384, stream) != hipSuccess) { fprintf(stderr, "kernel_launch: memset of barrier words failed\n"); return; }
    void* args[] = {&p};
    hipError_t e = hipLaunchCooperativeKernel((const void*)fwd_megakernel, dim3(grid), dim3(NTHREADS), args, LDS_BYTES, stream);
    if (e != hipSuccess) fprintf(stderr, "cooperative launch failed: %s (grid %d)\n", hipGetErrorString(e), grid);
}
```
